# Optimizing an MI355X kernel written in HIP

```python
import math
import jax, jax.numpy as jnp
from jax import lax
import numpy as np

D_MODEL = 1024
BATCH = 32
SEQ = 2048
DEPTH = 1

PLE_DIM = 256
D_FF = 2816
POOL_WIDTH = 512
POOL_WINDOWS = (2, 4, 8, 16)
POOL_GROUPS = len(POOL_WINDOWS)
POOL_GROUP_DIM = POOL_WIDTH // POOL_GROUPS
HEAD_DIM = 64
N_Q_HEADS = 8
N_KV_HEADS = 2
Q_PER_KV = N_Q_HEADS // N_KV_HEADS
ATTN_WIDTH = N_Q_HEADS * HEAD_DIM
KV_WIDTH = N_KV_HEADS * HEAD_DIM
WINDOW = 128
BLOCK = 128
MIX_IN = POOL_WIDTH + ATTN_WIDTH + 2 * KV_WIDTH
MIX_OUT = POOL_WIDTH + ATTN_WIDTH
EPS = 1e-6
NEG_INF = -1e30

kernel_name = "hymba_pool_swa_sink_macaron_ple"


def rms_norm(x, g):
    xf = x.astype(jnp.float32)
    y = xf * lax.rsqrt(jnp.mean(xf * xf, axis=-1, keepdims=True) + EPS)
    return (y * g.astype(jnp.float32)).astype(x.dtype)


def swiglu(h, w_gate, w_up, w_down):
    return (jax.nn.silu(h @ w_gate) * (h @ w_up)) @ w_down


def causal_pool_mixer(u, pool_w, pool_scale):
    B, S, _ = u.shape
    ug_all = u.reshape(B, S, POOL_GROUPS, POOL_GROUP_DIM)
    pos = jnp.arange(S)
    outs = []
    for g, win in enumerate(POOL_WINDOWS):
        ug = ug_all[:, :, g, :].astype(jnp.float32)
        c = jnp.cumsum(ug, axis=1)
        c_shift = jnp.pad(c, ((0, 0), (win, 0), (0, 0)))[:, :S]
        count = jnp.minimum(pos + 1, win).astype(jnp.float32)[None, :, None]
        outs.append(((c - c_shift) / count - ug).astype(u.dtype))
    d = jnp.stack(outs, axis=2)
    y = jnp.einsum('bsgc,gcd->bsgd', d, pool_w).reshape(B, S, POOL_WIDTH)
    return y * pool_scale


def sliding_window_sink_attention(q, k, v, sinks):
    B, S, _, _ = q.shape
    nb = S // BLOCK
    qb = q.reshape(B, nb, BLOCK, N_KV_HEADS, Q_PER_KV, HEAD_DIM)
    kb = k.reshape(B, nb, BLOCK, N_KV_HEADS, HEAD_DIM)
    vb = v.reshape(B, nb, BLOCK, N_KV_HEADS, HEAD_DIM)
    pad = ((0, 0), (1, 0), (0, 0), (0, 0), (0, 0))
    k_band = jnp.concatenate([jnp.pad(kb, pad)[:, :nb], kb], axis=2)
    v_band = jnp.concatenate([jnp.pad(vb, pad)[:, :nb], vb], axis=2)
    scale = 1.0 / math.sqrt(HEAD_DIM)
    scores = jnp.einsum('bnqkgd,bnskd->bnkgqs', qb, k_band).astype(jnp.float32) * scale
    i = jnp.arange(BLOCK)[:, None]
    j = jnp.arange(2 * BLOCK)[None, :]
    rel = i + BLOCK - j
    band = (rel >= 0) & (rel < WINDOW)
    has_prev = (jnp.arange(nb)[:, None, None] > 0) | (j >= BLOCK)[None]
    mask = band[None] & has_prev
    scores = jnp.where(mask[None, :, None, None], scores, NEG_INF)
    s = sinks.astype(jnp.float32).reshape(N_KV_HEADS, Q_PER_KV)[None, None, :, :, None, None]
    m = jnp.maximum(jnp.max(scores, axis=-1, keepdims=True), s)
    e = jnp.exp(scores - m)
    probs = e / (jnp.sum(e, axis=-1, keepdims=True) + jnp.exp(s - m))
    out = jnp.einsum('bnkgqs,bnskd->bnqkgd', probs.astype(v.dtype), v_band)
    return out.reshape(B, S, ATTN_WIDTH)


def setup_inputs(seed: int = 0) -> dict:
    key = jax.random.key(seed)
    ks = jax.random.split(key, 24)
    f32 = jnp.float32

    def w(k, shape, fan_in):
        return jax.random.normal(k, shape, f32) * (fan_in ** -0.5)

    def gain(k, shape):
        return 1.0 + 0.05 * jax.random.normal(k, shape, f32)

    L = DEPTH
    return {
        "x": jax.random.normal(ks[0], (BATCH, SEQ, D_MODEL), f32),
        "p": jax.random.normal(ks[1], (DEPTH, BATCH, SEQ, PLE_DIM), f32),
        "ffn1_norm": gain(ks[2], (L, D_MODEL)),
        "ffn1_w_gate": w(ks[3], (L, D_MODEL, D_FF), D_MODEL),
        "ffn1_w_up": w(ks[4], (L, D_MODEL, D_FF), D_MODEL),
        "ffn1_w_down": w(ks[5], (L, D_FF, D_MODEL), D_FF),
        "mix_norm": gain(ks[6], (L, D_MODEL)),
        "w_in": w(ks[7], (L, D_MODEL, MIX_IN), D_MODEL),
        "pool_w": w(ks[8], (L, POOL_GROUPS, POOL_GROUP_DIM, POOL_GROUP_DIM), POOL_GROUP_DIM),
        "pool_scale": gain(ks[9], (L, POOL_WIDTH)),
        "q_norm": gain(ks[10], (L, HEAD_DIM)),
        "k_norm": gain(ks[11], (L, HEAD_DIM)),
        "attn_sinks": jax.random.normal(ks[12], (L, N_Q_HEADS), f32),
        "pool_out_norm": gain(ks[13], (L, POOL_WIDTH)),
        "attn_out_norm": gain(ks[14], (L, ATTN_WIDTH)),
        "w_out": w(ks[15], (L, MIX_OUT, D_MODEL), MIX_OUT),
        "ffn2_norm": gain(ks[16], (L, D_MODEL)),
        "ffn2_w_gate": w(ks[17], (L, D_MODEL, D_FF), D_MODEL),
        "ffn2_w_up": w(ks[18], (L, D_MODEL, D_FF), D_MODEL),
        "ffn2_w_down": w(ks[19], (L, D_FF, D_MODEL), D_FF),
        "ple_norm": gain(ks[20], (L, D_MODEL)),
        "w_ple_gate": w(ks[21], (L, D_MODEL, D_MODEL), D_MODEL),
        "w_ple_proj": w(ks[22], (L, PLE_DIM, D_MODEL), PLE_DIM),
    }


def reference(x, p, ffn1_norm, ffn1_w_gate, ffn1_w_up, ffn1_w_down, mix_norm, w_in,
              pool_w, pool_scale, q_norm, k_norm, attn_sinks, pool_out_norm, attn_out_norm,
              w_out, ffn2_norm, ffn2_w_gate, ffn2_w_up, ffn2_w_down, ple_norm,
              w_ple_gate, w_ple_proj):
    B, S, _ = x.shape
    o_q = POOL_WIDTH
    o_k = o_q + ATTN_WIDTH
    o_v = o_k + KV_WIDTH
    for i in range(DEPTH):
        h = rms_norm(x, ffn1_norm[i])
        x = x + 0.5 * swiglu(h, ffn1_w_gate[i], ffn1_w_up[i], ffn1_w_down[i])

        h = rms_norm(x, mix_norm[i])
        z = h @ w_in[i]
        u = z[..., :o_q]
        q = z[..., o_q:o_k].reshape(B, S, N_Q_HEADS, HEAD_DIM)
        k = z[..., o_k:o_v].reshape(B, S, N_KV_HEADS, HEAD_DIM)
        v = z[..., o_v:].reshape(B, S, N_KV_HEADS, HEAD_DIM)

        pool_y = causal_pool_mixer(u, pool_w[i], pool_scale[i])
        q = rms_norm(q, q_norm[i])
        k = rms_norm(k, k_norm[i])
        attn_y = sliding_window_sink_attention(q, k, v, attn_sinks[i])

        merged = jnp.concatenate([rms_norm(pool_y, pool_out_norm[i]),
                                  rms_norm(attn_y, attn_out_norm[i])], axis=-1)
        x = x + merged @ w_out[i]

        h = rms_norm(x, ffn2_norm[i])
        x = x + 0.5 * swiglu(h, ffn2_w_gate[i], ffn2_w_up[i], ffn2_w_down[i])

        gate = jax.nn.sigmoid(rms_norm(x, ple_norm[i]) @ w_ple_gate[i])
        x = x + gate * (p[i] @ w_ple_proj[i])
    return x
```

```cpp
#include <hip/hip_runtime.h>
#include <hip/hip_cooperative_groups.h>
#include <cstdio>
#include <cstdint>
namespace cg = cooperative_groups;

#ifndef MK_N_LAUNCHES
#define MK_N_LAUNCHES 1
#endif

#define LAS __attribute__((address_space(3)))
typedef unsigned short bf16_t;
typedef short bf16x8 __attribute__((ext_vector_type(8)));
typedef float f32x4 __attribute__((ext_vector_type(4)));
typedef float f32x2 __attribute__((ext_vector_type(2)));
typedef float f32x16 __attribute__((ext_vector_type(16)));
typedef unsigned u32x4 __attribute__((ext_vector_type(4)));
typedef unsigned u32x2 __attribute__((ext_vector_type(2)));
typedef __bf16 bf16x2_t __attribute__((ext_vector_type(2)));

__device__ __forceinline__ unsigned pk2(float lo, float hi) { f32x2 v = {lo, hi}; bf16x2_t b = __builtin_convertvector(v, bf16x2_t); return __builtin_bit_cast(unsigned, b); }
__device__ __forceinline__ float bf_lo(unsigned w) { return __builtin_bit_cast(float, w << 16); }
__device__ __forceinline__ float bf_hi(unsigned w) { return __builtin_bit_cast(float, w & 0xffff0000u); }
__device__ __forceinline__ float fast_exp2(float x) { return __builtin_amdgcn_exp2f(x); }
__device__ __forceinline__ float fast_rcp(float x) { return __builtin_amdgcn_rcpf(x); }
__device__ __forceinline__ float fast_rsq(float x) { return __builtin_amdgcn_rsqf(x); }
__device__ __forceinline__ void atomic_addf(float* p, float v) { __hip_atomic_fetch_add(p, v, __ATOMIC_RELAXED, __HIP_MEMORY_SCOPE_AGENT); }

constexpr int T = 65536, DM = 1024, FF = 2816, NGU = 2 * FF, MIXIN = 1280, SEQ = 2048, PLE = 256, POOLW = 512;
constexpr float EPS = 1e-6f, LOG2E = 1.4426950408889634f;

namespace pg8 {
constexpr int BM = 256, BK = 64, HALF = 128, HTB = HALF * BK * 2, STAGE_BYTES = 8 * HTB, NXCD = 8, WGM = 8;
__host__ __device__ __forceinline__ int lds_byte(int r, int c) { const int st = (r >> 4) * 2 + (c >> 5), rr = r & 15, cc = c & 31, ob = rr * 64 + cc * 2; return st * 1024 + (ob ^ (((ob >> 9) & 1) << 5)); }
__host__ __device__ __forceinline__ void stage_rc(int b, int& R, int& C) { const int st = b / 1024, sb = b % 1024, swz = sb ^ (((sb >> 9) & 1) << 5); R = (st >> 1) * 16 + swz / 64; C = (st & 1) * 32 + (swz % 64) / 2; }
__host__ __device__ __forceinline__ int perm32(int rho) { const int n = rho >> 4, i = rho & 15; return 8 * (i >> 2) + 4 * n + (i & 3); }

struct Unit { int pm, pn; };
struct Gemm { const bf16_t* A; const bf16_t* Bt; int M, N, K; };

struct StaticOrder {
    int nM, nN, nwg, G, c;
    __host__ __device__ void init(int M, int N, int G_, int c_) { nM = M / BM; nN = N / BM; nwg = nM * nN; G = G_; c = c_; }
    __host__ __device__ bool next(int i, Unit& u) const {
        const long L = (long)i * G + c; if (L >= nwg) return false;
        int wgid = (int)L; { const int q = nwg / NXCD, r = nwg % NXCD, xcd = wgid % NXCD, off = wgid / NXCD; wgid = (xcd < r ? xcd * (q + 1) : r * (q + 1) + (xcd - r) * q) + off; }
        const int nig = WGM * nN, gid = wgid / nig, fm = gid * WGM, gsz = (nM - fm) < WGM ? (nM - fm) : WGM;
        u.pm = fm + ((wgid % nig) % gsz); u.pn = (wgid % nig) / gsz; return true;
    }
};

typedef f32x4 Acc[2][2][4][2];

__device__ __forceinline__ u32x4 pack8(const f32x4 a, const f32x4 b) { u32x4 w; w.x = pk2(a[0], a[1]); w.y = pk2(a[2], a[3]); w.z = pk2(b[0], b[1]); w.w = pk2(b[2], b[3]); return w; }
__device__ __forceinline__ float sq4(const f32x4 a) { return (a[0] * a[0] + a[1] * a[1]) + (a[2] * a[2] + a[3] * a[3]); }

struct EpiSwiGLU {
    static constexpr bool PERM = true, MID = false;
    bf16_t* O; const float* ss;
    __device__ __forceinline__ void mid(Acc&, const Unit&, int, int) const {}
    __device__ __forceinline__ void operator()(const Acc& acc, const Unit& u, int wr, int wc, int fr, int fq) const {
        asm volatile("" : "+v"(fr), "+v"(fq));
        const int row0 = u.pm * BM + wr * 64 + fr, col0 = u.pn * 128 + wc * 32 + 8 * fq;
#pragma unroll
        for (int ai = 0; ai < 2; ++ai)
#pragma unroll
            for (int m = 0; m < 4; ++m) {
                const int row = row0 + ai * HALF + m * 16; const float r = fast_rsq(ss[row] * (1.0f / DM) + EPS);
                f32x4 o[2];
#pragma unroll
                for (int n = 0; n < 2; ++n) { const f32x4 g = acc[ai][0][m][n] * r, up = acc[ai][1][m][n] * r;
#pragma unroll
                    for (int j = 0; j < 4; ++j) o[n][j] = g[j] * up[j] * fast_rcp(1.0f + fast_exp2(-LOG2E * g[j])); }
                *(u32x4*)(O + (unsigned)(row * FF + col0)) = pack8(o[0], o[1]);
            }
    }
};
template <bool ROWSCALE> struct EpiResid {
    static constexpr bool PERM = true, MID = ROWSCALE;
    const float* xin; float* xout; bf16_t* xb; float* ss_out; float alpha; const float* ssp; const float* ssa;
    __device__ __forceinline__ void mid(Acc& acc, const Unit& u, int wr, int fr) const {
        asm volatile("" : "+v"(fr));
        const int row0 = u.pm * BM + wr * 64 + fr;
#pragma unroll
        for (int ai = 0; ai < 2; ++ai)
#pragma unroll
            for (int m = 0; m < 4; ++m) { const int row = row0 + ai * HALF + m * 16;
                const float vp = ssp[row] * (1.0f / 512.0f) + EPS, va = ssa[row] * (1.0f / 512.0f) + EPS; const float ratio = __builtin_sqrtf(va * fast_rcp(vp));
#pragma unroll
                for (int bj = 0; bj < 2; ++bj)
#pragma unroll
                    for (int n = 0; n < 2; ++n) acc[ai][bj][m][n] *= ratio; }
    }
    __device__ __forceinline__ void operator()(const Acc& acc, const Unit& u, int wr, int wc, int fr, int fq) const {
        asm volatile("" : "+v"(fr), "+v"(fq));
        const int row0 = u.pm * BM + wr * 64 + fr, col0 = u.pn * BM + wc * 32 + 8 * fq;
#pragma unroll
        for (int ai = 0; ai < 2; ++ai)
#pragma unroll
            for (int m = 0; m < 4; ++m) {
                const int row = row0 + ai * HALF + m * 16;
                float rs = alpha; if (ROWSCALE) rs *= fast_rsq(ssa[row] * (1.0f / 512.0f) + EPS);
                float s = 0.f;
#pragma unroll
                for (int bj = 0; bj < 2; ++bj) { const unsigned off = (unsigned)(row * DM + col0 + bj * HALF);
                    const f32x4 x0 = *(const f32x4*)(xin + off), x1 = *(const f32x4*)(xin + off + 4);
                    const f32x4 o0 = x0 + rs * acc[ai][bj][m][0], o1 = x1 + rs * acc[ai][bj][m][1];
                    *(f32x4*)(xout + off) = o0; *(f32x4*)(xout + off + 4) = o1; *(u32x4*)(xb + off) = pack8(o0, o1);
                    s += sq4(o0) + sq4(o1); }
                s += __shfl_xor(s, 16); s += __shfl_xor(s, 32);
                if (fq == 0) atomic_addf(ss_out + row, s);
                asm volatile("" ::: "memory");
            }
    }
};
struct EpiScaleBf16 {
    static constexpr bool PERM = true, MID = false;
    bf16_t* O; int ldc; const float* ss;
    __device__ __forceinline__ void mid(Acc&, const Unit&, int, int) const {}
    __device__ __forceinline__ void operator()(const Acc& acc, const Unit& u, int wr, int wc, int fr, int fq) const {
        asm volatile("" : "+v"(fr), "+v"(fq));
        const int row0 = u.pm * BM + wr * 64 + fr, col0 = u.pn * BM + wc * 32 + 8 * fq;
#pragma unroll
        for (int ai = 0; ai < 2; ++ai)
#pragma unroll
            for (int m = 0; m < 4; ++m) { const int row = row0 + ai * HALF + m * 16; const float r = ss ? fast_rsq(ss[row] * (1.0f / DM) + EPS) : 1.0f;
#pragma unroll
                for (int bj = 0; bj < 2; ++bj) *(u32x4*)(O + (unsigned)(row * ldc + col0 + bj * HALF)) = pack8(acc[ai][bj][m][0] * r, acc[ai][bj][m][1] * r); }
    }
};
struct EpiPool {
    static constexpr bool PERM = true, MID = false;
    bf16_t* O; const float* pscale; float* ss_out;
    __device__ __forceinline__ void mid(Acc&, const Unit&, int, int) const {}
    __device__ __forceinline__ void operator()(const Acc& acc, const Unit& u, int wr, int wc, int fr, int fq) const {
        asm volatile("" : "+v"(fr), "+v"(fq));
        const int row0 = u.pm * BM + wr * 64 + fr, col0 = u.pn * BM + wc * 32 + 8 * fq;
        f32x4 ps[2][2];
#pragma unroll
        for (int bj = 0; bj < 2; ++bj)
#pragma unroll
            for (int n = 0; n < 2; ++n) ps[bj][n] = *(const f32x4*)(pscale + col0 + bj * HALF + 4 * n);
#pragma unroll
        for (int ai = 0; ai < 2; ++ai)
#pragma unroll
            for (int m = 0; m < 4; ++m) { const int row = row0 + ai * HALF + m * 16; float s = 0.f;
#pragma unroll
                for (int bj = 0; bj < 2; ++bj) { const f32x4 o0 = acc[ai][bj][m][0] * ps[bj][0], o1 = acc[ai][bj][m][1] * ps[bj][1];
                    *(u32x4*)(O + (unsigned)(row * DM + col0 + bj * HALF)) = pack8(o0, o1); s += sq4(o0) + sq4(o1); }
                s += __shfl_xor(s, 16); s += __shfl_xor(s, 32);
                if (fq == 0) atomic_addf(ss_out + row, s); }
    }
};
struct EpiFinal {
    static constexpr bool PERM = true, MID = false;
    float* xio; const bf16_t* P; const float* ss;
    __device__ __forceinline__ void mid(Acc&, const Unit&, int, int) const {}
    __device__ __forceinline__ void operator()(const Acc& acc, const Unit& u, int wr, int wc, int fr, int fq) const {
        asm volatile("" : "+v"(fr), "+v"(fq));
        const int row0 = u.pm * BM + wr * 64 + fr, col0 = u.pn * BM + wc * 32 + 8 * fq;
#pragma unroll
        for (int ai = 0; ai < 2; ++ai)
#pragma unroll
            for (int m = 0; m < 4; ++m) { const int row = row0 + ai * HALF + m * 16; const float r = -LOG2E * fast_rsq(ss[row] * (1.0f / DM) + EPS);
#pragma unroll
                for (int bj = 0; bj < 2; ++bj) { const unsigned off = (unsigned)(row * DM + col0 + bj * HALF);
                    const f32x4 x0 = *(const f32x4*)(xio + off), x1 = *(const f32x4*)(xio + off + 4); const u32x4 pw = *(const u32x4*)(P + off);
                    const f32x4 p0 = {bf_lo(pw.x), bf_hi(pw.x), bf_lo(pw.y), bf_hi(pw.y)}, p1 = {bf_lo(pw.z), bf_hi(pw.z), bf_lo(pw.w), bf_hi(pw.w)};
                    f32x4 o0, o1;
#pragma unroll
                    for (int j = 0; j < 4; ++j) { o0[j] = x0[j] + p0[j] * fast_rcp(1.0f + fast_exp2(r * acc[ai][bj][m][0][j])); o1[j] = x1[j] + p1[j] * fast_rcp(1.0f + fast_exp2(r * acc[ai][bj][m][1][j])); }
                    *(f32x4*)(xio + off) = o0; *(f32x4*)(xio + off + 4) = o1; }
                asm volatile("" ::: "memory"); }
    }
};

template <class Epi, class Sched, bool ALIGN_EPI = true, bool SP2 = true>
__device__ __forceinline__ void gemm_phase(LAS unsigned char* lds, const Gemm g, const Sched& S, const Epi& E) {
    const int tid = threadIdx.x, wid = __builtin_amdgcn_readfirstlane(tid >> 6), lane = tid & 63, wr = wid >> 2, wc = wid & 3, fr = lane & 15, fq = lane >> 4;
    const int K = g.K, nt = K / BK;
    unsigned voffA[2], voffB[2];
#pragma unroll
    for (int i = 0; i < 2; ++i) { int R, C; stage_rc(tid * 16 + i * 8192, R, C); const int Rb = Epi::PERM ? ((R & ~31) + perm32(R & 31)) : R;
        voffA[i] = (unsigned)(R * K + C) * 2u; voffB[i] = (unsigned)(Rb * K + C) * 2u; }
    const size_t kstep = (size_t)(BK * 2);
    const size_t hstep = (size_t)HALF * K * 2;
    const size_t tstep = 2 * hstep;
    const unsigned ldsw = (unsigned)wid * 1024u;
    const int aoff = lds_byte(wr * 64 + fr, fq * 8), boff = lds_byte(wc * 32 + fr, fq * 8);
#define PG8_SA(b, h) (((b) * 2 + (h)) * HTB)
#define PG8_SB(b, h) ((4 + (b) * 2 + (h)) * HTB)
#define PG8_STAGE(bufoff, gbase, voff) do { _Pragma("unroll") for (int _i = 0; _i < 2; ++_i) \
        __builtin_amdgcn_global_load_lds((const unsigned*)((const char*)(gbase) + (voff)[_i]), (LAS unsigned*)(lds + (bufoff) + ldsw + _i * 8192), 16, 0, 0); } while (0)
#define PG8_LDA(dst, b, h) do { _Pragma("unroll") for (int m = 0; m < 4; ++m) _Pragma("unroll") for (int k = 0; k < 2; ++k) dst[m][k] = *(const LAS bf16x8*)(lds + PG8_SA(b, h) + aoff + m * 2048 + k * 1024); } while (0)
#define PG8_LDB(dst, b, h) do { _Pragma("unroll") for (int n = 0; n < 2; ++n) _Pragma("unroll") for (int k = 0; k < 2; ++k) dst[n][k] = *(const LAS bf16x8*)(lds + PG8_SB(b, h) + boff + n * 2048 + k * 1024); } while (0)
#define PG8_MMA(ai, bj, At, Bt) do { __builtin_amdgcn_s_setprio(1); _Pragma("unroll") for (int m = 0; m < 4; ++m) _Pragma("unroll") for (int n = 0; n < 2; ++n) _Pragma("unroll") for (int k = 0; k < 2; ++k) \
        acc[ai][bj][m][n] = __builtin_amdgcn_mfma_f32_16x16x32_bf16(Bt[n][k], At[m][k], acc[ai][bj][m][n], 0, 0, 0); __builtin_amdgcn_s_setprio(0); } while (0)
#define PG8_WAIT_V(n) asm volatile("s_waitcnt vmcnt(" #n ")" ::: "memory")
#define PG8_WAIT_L(n) asm volatile("s_waitcnt lgkmcnt(" #n ")" ::: "memory")
#define PG8_BAR __builtin_amdgcn_s_barrier()
#define PG8_SCHED __builtin_amdgcn_sched_barrier(0)
    Unit cur, nxt; int ui = 0;
    if (!S.next(0, cur)) return;
    Acc acc;
#pragma unroll
    for (int a = 0; a < 2; ++a)
#pragma unroll
        for (int b = 0; b < 2; ++b)
#pragma unroll
            for (int m = 0; m < 4; ++m)
#pragma unroll
                for (int n = 0; n < 2; ++n) acc[a][b][m][n] = (f32x4){0.f, 0.f, 0.f, 0.f};
    bf16x8 At[4][2], B0[2][2], B1[2][2];
    const char* cA = (const char*)g.A + (size_t)cur.pm * tstep; const char* cB = (const char*)g.Bt + (size_t)cur.pn * tstep;
    if constexpr (SP2) {
        PG8_STAGE(PG8_SB(0, 0), cB, voffB); PG8_STAGE(PG8_SB(0, 1), cB + hstep, voffB); PG8_STAGE(PG8_SA(0, 0), cA, voffA); PG8_STAGE(PG8_SA(0, 1), cA + hstep, voffA);
        if (wr == 1) PG8_BAR;
        PG8_WAIT_V(2); PG8_BAR;
        PG8_STAGE(PG8_SB(1, 0), cB + kstep, voffB); PG8_STAGE(PG8_SA(1, 0), cA + kstep, voffA); PG8_STAGE(PG8_SB(1, 1), cB + hstep + kstep, voffB);
        PG8_WAIT_V(6); PG8_BAR;
    } else {
        PG8_STAGE(PG8_SB(0, 0), cB, voffB); PG8_STAGE(PG8_SA(0, 0), cA, voffA); PG8_STAGE(PG8_SB(0, 1), cB + hstep, voffB); PG8_STAGE(PG8_SA(0, 1), cA + hstep, voffA);
        if (wr == 1) PG8_BAR;
        PG8_WAIT_V(4); PG8_BAR;
        PG8_STAGE(PG8_SB(1, 0), cB + kstep, voffB); PG8_STAGE(PG8_SA(1, 0), cA + kstep, voffA); PG8_STAGE(PG8_SB(1, 1), cB + hstep + kstep, voffB);
        PG8_WAIT_V(6); PG8_BAR;
    }
    for (;;) {
        const bool has_next = S.next(ui + 1, nxt);
        const char* nA = has_next ? (const char*)g.A + (size_t)nxt.pm * tstep : cA; const char* nB = has_next ? (const char*)g.Bt + (size_t)nxt.pn * tstep : cB;
        for (int t = 0; t < nt; t += 2) {
            const bool last = (t == nt - 2);
            const char* a1 = cA + (size_t)(t + 1) * kstep;
            const char* a2 = last ? nA : cA + (size_t)(t + 2) * kstep; const char* b2 = last ? nB : cB + (size_t)(t + 2) * kstep;
            const char* a3 = a2 + kstep; const char* b3 = b2 + kstep;
            if constexpr (Epi::MID) { if (t == (nt >> 1)) E.mid(acc, cur, wr, fr); }
            if constexpr (SP2) {
            PG8_LDB(B0, 0, 0); PG8_LDB(B1, 0, 1); PG8_SCHED; PG8_LDA(At, 0, 0); PG8_STAGE(PG8_SA(1, 1), a1 + hstep, voffA);
            PG8_WAIT_V(8); PG8_WAIT_L(0); PG8_BAR; PG8_MMA(0, 0, At, B0); PG8_MMA(0, 1, At, B1); PG8_BAR; PG8_SCHED;
            PG8_LDA(At, 0, 1); PG8_STAGE(PG8_SB(0, 0), b2, voffB); PG8_STAGE(PG8_SB(0, 1), b2 + hstep, voffB); PG8_STAGE(PG8_SA(0, 0), a2, voffA);
            PG8_WAIT_V(8); PG8_WAIT_L(0); PG8_BAR; PG8_MMA(1, 0, At, B0); PG8_MMA(1, 1, At, B1); PG8_BAR; PG8_SCHED;
            PG8_LDB(B0, 1, 0); PG8_LDB(B1, 1, 1); PG8_SCHED; PG8_LDA(At, 1, 0); PG8_STAGE(PG8_SA(0, 1), a2 + hstep, voffA);
            PG8_WAIT_V(8); PG8_WAIT_L(0); PG8_BAR; PG8_MMA(0, 0, At, B0); PG8_MMA(0, 1, At, B1); PG8_BAR; PG8_SCHED;
            PG8_LDA(At, 1, 1); PG8_STAGE(PG8_SB(1, 0), b3, voffB); PG8_STAGE(PG8_SB(1, 1), b3 + hstep, voffB); PG8_STAGE(PG8_SA(1, 0), a3, voffA);
            PG8_WAIT_V(8); PG8_WAIT_L(0); PG8_BAR; PG8_MMA(1, 0, At, B0); PG8_MMA(1, 1, At, B1); PG8_BAR; PG8_SCHED;
            } else {
            PG8_LDB(B0, 0, 0); PG8_SCHED; PG8_LDA(At, 0, 0); PG8_STAGE(PG8_SA(1, 1), a1 + hstep, voffA);
            PG8_WAIT_L(8); PG8_BAR; PG8_WAIT_L(0); PG8_MMA(0, 0, At, B0); PG8_BAR; PG8_SCHED;
            PG8_LDB(B1, 0, 1); PG8_STAGE(PG8_SB(0, 0), b2, voffB);
            PG8_BAR; PG8_WAIT_L(0); PG8_MMA(0, 1, At, B1); PG8_BAR;
            PG8_LDA(At, 0, 1); PG8_STAGE(PG8_SA(0, 0), a2, voffA);
            PG8_BAR; PG8_WAIT_L(0); PG8_MMA(1, 0, At, B0); PG8_BAR; PG8_SCHED;
            PG8_STAGE(PG8_SB(0, 1), b2 + hstep, voffB);
            PG8_WAIT_V(6); PG8_BAR; PG8_MMA(1, 1, At, B1); PG8_BAR;
            PG8_LDB(B0, 1, 0); PG8_SCHED; PG8_LDA(At, 1, 0); PG8_STAGE(PG8_SA(0, 1), a2 + hstep, voffA);
            PG8_WAIT_L(8); PG8_BAR; PG8_WAIT_L(0); PG8_MMA(0, 0, At, B0); PG8_BAR; PG8_SCHED;
            PG8_LDB(B1, 1, 1); PG8_STAGE(PG8_SB(1, 0), b3, voffB);
            PG8_BAR; PG8_WAIT_L(0); PG8_MMA(0, 1, At, B1); PG8_BAR;
            PG8_LDA(At, 1, 1); PG8_STAGE(PG8_SA(1, 0), a3, voffA);
            PG8_BAR; PG8_WAIT_L(0); PG8_MMA(1, 0, At, B0); PG8_BAR; PG8_SCHED;
            PG8_STAGE(PG8_SB(1, 1), b3 + hstep, voffB);
            PG8_WAIT_V(6); PG8_BAR; PG8_MMA(1, 1, At, B1); PG8_BAR;
            }
        }
        if constexpr (ALIGN_EPI) { if (wr == 0) PG8_BAR; }
        E(acc, cur, wr, wc, fr, fq);
        if (!has_next) break;
#pragma unroll
        for (int a = 0; a < 2; ++a)
#pragma unroll
            for (int b = 0; b < 2; ++b)
#pragma unroll
                for (int m = 0; m < 4; ++m)
#pragma unroll
                    for (int n = 0; n < 2; ++n) acc[a][b][m][n] = (f32x4){0.f, 0.f, 0.f, 0.f};
        cur = nxt; cA = nA; cB = nB; ++ui;
        if constexpr (ALIGN_EPI) { if (wr == 1) PG8_BAR; }
    }
    PG8_WAIT_V(0);
    if constexpr (!ALIGN_EPI) { if (wr == 0) PG8_BAR; }
    PG8_BAR;
#undef PG8_SA
#undef PG8_SB
#undef PG8_STAGE
#undef PG8_LDA
#undef PG8_LDB
#undef PG8_MMA
#undef PG8_WAIT_V
#undef PG8_WAIT_L
#undef PG8_BAR
#undef PG8_SCHED
}
}

constexpr size_t MiB = 1u << 20;
constexpr size_t WS_SS = 0;
constexpr size_t WS_WGU1 = 2 * MiB, WS_WD1 = 13 * MiB, WS_WGU2 = 19 * MiB, WS_WD2 = 30 * MiB, WS_WIN = 36 * MiB, WS_WOUT = 39 * MiB, WS_WPG = 41 * MiB, WS_WPP = 43 * MiB, WS_WPOOL = 44 * MiB;
constexpr size_t WS_XB = 48 * MiB;
constexpr size_t WS_PB = 176 * MiB;
constexpr size_t WS_PP = 208 * MiB;
constexpr size_t WS_ACT = 336 * MiB;
constexpr size_t WS_Z = 336 * MiB, WS_DP = 496 * MiB, WS_MG = 560 * MiB, WS_END = 688 * MiB;
constexpr int LDS_BYTES = 147456;
constexpr int NPHASE = 10;

struct Args { const float* in[23]; float* out; unsigned char* ws; int ph_lo, ph_hi; };

__device__ __forceinline__ float wave_sum(float v) {
#pragma unroll
    for (int o = 1; o < 64; o <<= 1) v += __shfl_xor(v, o);
    return v;
}

__device__ __forceinline__ void transpose_item(const float* W, int ldw, const float* gain, bf16_t* dst, int ldd, LAS float* scr, int lane, bool zero) {
    if (!zero) {
#pragma unroll 8
        for (int i = 0; i < 32; ++i) { const int kk = 2 * i + (lane >> 5); float v = W[(size_t)kk * ldw + (lane & 31)]; if (gain) v *= gain[kk]; scr[kk * 33 + (lane & 31)] = v; }
    }
    asm volatile("s_waitcnt lgkmcnt(0)" ::: "memory");
    const int c = lane & 7;
#pragma unroll
    for (int j = 0; j < 4; ++j) { const int n = (lane >> 3) + 8 * j; const LAS float* s = scr + (8 * c) * 33 + n;
        u32x4 o = {0u, 0u, 0u, 0u};
        if (!zero) { o.x = pk2(s[0 * 33], s[1 * 33]); o.y = pk2(s[2 * 33], s[3 * 33]); o.z = pk2(s[4 * 33], s[5 * 33]); o.w = pk2(s[6 * 33], s[7 * 33]); }
        *(u32x4*)(dst + (size_t)n * ldd + 8 * c) = o; }
    asm volatile("s_waitcnt lgkmcnt(0)" ::: "memory");
}

__device__ __forceinline__ void p0_prep(const Args& a, LAS unsigned char* lds, int G) {
    const int tid = threadIdx.x, lane = tid & 63, wave = tid >> 6;
    unsigned char* ws = a.ws;
    LAS float* scr = (LAS float*)(lds + wave * 16384);
    const int gw = blockIdx.x * 8 + wave, NGW = G * 8;
    constexpr int I_GU = (DM / 64) * (FF / 32), I_DN = (FF / 64) * (DM / 32), I_IN = (DM / 64) * (MIXIN / 32), I_SQ = (DM / 64) * (DM / 32), I_PP = (PLE / 64) * (DM / 32), I_PL = (POOLW / 64) * (POOLW / 32);
    constexpr int NITEMS = 4 * I_GU + 2 * I_DN + I_IN + 2 * I_SQ + I_PP + I_PL;
    for (int it = gw; it < NITEMS; it += NGW) {
        int r = it;
        if (r < 4 * I_GU) {
            const int which = r / I_GU; r -= which * I_GU; const int nblk = FF / 32, kb = r / nblk, nb = r % nblk, k0 = 64 * kb, n0 = 32 * nb;
            const float* W = a.in[which == 0 ? 3 : which == 1 ? 4 : which == 2 ? 17 : 18]; const float* gain = a.in[which < 2 ? 2 : 16];
            bf16_t* dst = (bf16_t*)(ws + (which < 2 ? WS_WGU1 : WS_WGU2)); const int drow = (n0 / 128) * 256 + (which & 1) * 128 + (n0 % 128);
            transpose_item(W + (size_t)k0 * FF + n0, FF, gain + k0, dst + (size_t)drow * DM + k0, DM, scr, lane, false); continue; }
        r -= 4 * I_GU;
        if (r < 2 * I_DN) {
            const int which = r / I_DN; r -= which * I_DN; const int nblk = DM / 32, kb = r / nblk, nb = r % nblk, k0 = 64 * kb, n0 = 32 * nb;
            const float* W = a.in[which == 0 ? 5 : 19]; bf16_t* dst = (bf16_t*)(ws + (which == 0 ? WS_WD1 : WS_WD2));
            transpose_item(W + (size_t)k0 * DM + n0, DM, nullptr, dst + (size_t)n0 * FF + k0, FF, scr, lane, false); continue; }
        r -= 2 * I_DN;
        if (r < I_IN) { const int nblk = MIXIN / 32, kb = r / nblk, nb = r % nblk, k0 = 64 * kb, n0 = 32 * nb;
            transpose_item(a.in[7] + (size_t)k0 * MIXIN + n0, MIXIN, a.in[6] + k0, (bf16_t*)(ws + WS_WIN) + (size_t)n0 * DM + k0, DM, scr, lane, false); continue; }
        r -= I_IN;
        if (r < I_SQ) { const int nblk = DM / 32, kb = r / nblk, nb = r % nblk, k0 = 64 * kb, n0 = 32 * nb;
            const float* gain = (k0 < 512) ? a.in[13] + k0 : a.in[14] + (k0 - 512);
            transpose_item(a.in[15] + (size_t)k0 * DM + n0, DM, gain, (bf16_t*)(ws + WS_WOUT) + (size_t)n0 * DM + k0, DM, scr, lane, false); continue; }
        r -= I_SQ;
        if (r < I_SQ) { const int nblk = DM / 32, kb = r / nblk, nb = r % nblk, k0 = 64 * kb, n0 = 32 * nb;
            transpose_item(a.in[21] + (size_t)k0 * DM + n0, DM, a.in[20] + k0, (bf16_t*)(ws + WS_WPG) + (size_t)n0 * DM + k0, DM, scr, lane, false); continue; }
        r -= I_SQ;
        if (r < I_PP) { const int nblk = DM / 32, kb = r / nblk, nb = r % nblk, k0 = 64 * kb, n0 = 32 * nb;
            transpose_item(a.in[22] + (size_t)k0 * DM + n0, DM, nullptr, (bf16_t*)(ws + WS_WPP) + (size_t)n0 * PLE + k0, PLE, scr, lane, false); continue; }
        r -= I_PP;
        { const int nblk = POOLW / 32, kb = r / nblk, nb = r % nblk, k0 = 64 * kb, n0 = 32 * nb, gk = k0 / 128, gn = n0 / 128;
            transpose_item(a.in[8] + (size_t)gk * 128 * 128 + (size_t)(k0 % 128) * 128 + (n0 % 128), 128, nullptr, (bf16_t*)(ws + WS_WPOOL) + (size_t)n0 * POOLW + k0, POOLW, scr, lane, gk != gn); }
    }
    float* ss = (float*)(ws + WS_SS);
    bf16_t* xb = (bf16_t*)(ws + WS_XB); bf16_t* pb = (bf16_t*)(ws + WS_PB);
    for (int m = gw; m < T; m += NGW) {
        const f32x4* xr = (const f32x4*)(a.in[0] + (size_t)m * DM) + lane; f32x4 v[4]; float s = 0.f;
#pragma unroll
        for (int j = 0; j < 4; ++j) { v[j] = xr[64 * j]; s += pg8::sq4(v[j]); }
        u32x2* o8 = (u32x2*)(xb + (size_t)m * DM) + lane;
#pragma unroll
        for (int j = 0; j < 4; ++j) { u32x2 w; w.x = pk2(v[j][0], v[j][1]); w.y = pk2(v[j][2], v[j][3]); o8[64 * j] = w; }
        s = wave_sum(s); if (lane == 0) ss[m] = s;
        const f32x4 pv = *((const f32x4*)(a.in[1] + (size_t)m * PLE) + lane); u32x2 w; w.x = pk2(pv[0], pv[1]); w.y = pk2(pv[2], pv[3]);
        *((u32x2*)(pb + (size_t)m * PLE) + lane) = w;
    }
    for (int i = blockIdx.x * 512 + tid; i < 5 * T; i += G * 512) ss[T + i] = 0.f;
}

__device__ __forceinline__ void p4_pool_diff(const bf16_t* z, bf16_t* dp, int G) {
    for (int idx = blockIdx.x * 512 + threadIdx.x; idx < T * 64; idx += G * 512) {
        const int tok = idx >> 6, ch = idx & 63, g = ch >> 4, win = 2 << g, s = tok & (SEQ - 1); const int cnt = (s + 1) < win ? (s + 1) : win;
        const bf16_t* zp = z + (size_t)tok * MIXIN + ch * 8;
        float acc[8]; float self[8];
#pragma unroll
        for (int e = 0; e < 8; ++e) acc[e] = 0.f;
        for (int w = 0; w < cnt; ++w) { const u32x4 r = *(const u32x4*)(zp - (size_t)w * MIXIN);
            const float f[8] = {bf_lo(r.x), bf_hi(r.x), bf_lo(r.y), bf_hi(r.y), bf_lo(r.z), bf_hi(r.z), bf_lo(r.w), bf_hi(r.w)};
#pragma unroll
            for (int e = 0; e < 8; ++e) { acc[e] += f[e]; if (w == 0) self[e] = f[e]; } }
        const float inv = 1.0f / (float)cnt; u32x4 o;
        o.x = pk2(acc[0] * inv - self[0], acc[1] * inv - self[1]); o.y = pk2(acc[2] * inv - self[2], acc[3] * inv - self[3]);
        o.z = pk2(acc[4] * inv - self[4], acc[5] * inv - self[5]); o.w = pk2(acc[6] * inv - self[6], acc[7] * inv - self[7]);
        *(u32x4*)(dp + (size_t)tok * POOLW + ch * 8) = o;
    }
}

constexpr int ATT_KS = 144, ATT_VS = 392, ATT_KBYTES = 2 * 192 * ATT_KS;
__device__ __forceinline__ void p5_attention(LAS unsigned char* lds, const bf16_t* z, bf16_t* merged, float* ssa, const float* qn, const float* kn, const float* sinks, int G) {
    const int tid = threadIdx.x, lane = tid & 63, wave = __builtin_amdgcn_readfirstlane(tid >> 6);
    const int c = tid & 31, r0 = tid >> 5; const bool isK = c < 16; const int kvh_s = (c & 15) >> 3, d8 = c & 7;
    float gprod[8];
#pragma unroll
    for (int e = 0; e < 8; ++e) gprod[e] = qn[d8 * 8 + e] * kn[d8 * 8 + e];
    const int h = wave, kvh = h >> 2, qq = lane & 31, hh = lane >> 5;
    const float sink2 = sinks[h] * LOG2E;
    for (int item = blockIdx.x; item < (T / 64); item += G) {
        const int b = item >> 5, rem = item & 31, n = rem >> 1, half = rem & 1;
        const int tok0 = b * SEQ + n * 128 + 64 * half;
#pragma unroll 4
        for (int it = 0; it < 12; ++it) {
            const int kk = r0 + 16 * it; const bool valid = (n > 0) || (64 * half + kk >= 128);
            u32x4 raw = {0u, 0u, 0u, 0u};
            if (valid) raw = *(const u32x4*)(z + (size_t)(tok0 - 128 + kk) * MIXIN + 1024 + c * 8);
            const float f[8] = {bf_lo(raw.x), bf_hi(raw.x), bf_lo(raw.y), bf_hi(raw.y), bf_lo(raw.z), bf_hi(raw.z), bf_lo(raw.w), bf_hi(raw.w)};
            float s = 0.f;
#pragma unroll
            for (int e = 0; e < 8; ++e) s += f[e] * f[e];
            s += __shfl_xor(s, 1); s += __shfl_xor(s, 2); s += __shfl_xor(s, 4);
            if (isK) { const float r = fast_rsq(s * (1.0f / 64.0f) + EPS); u32x4 o;
                o.x = pk2(f[0] * r * gprod[0], f[1] * r * gprod[1]); o.y = pk2(f[2] * r * gprod[2], f[3] * r * gprod[3]);
                o.z = pk2(f[4] * r * gprod[4], f[5] * r * gprod[5]); o.w = pk2(f[6] * r * gprod[6], f[7] * r * gprod[7]);
                *(LAS u32x4*)(lds + (kvh_s * 192 + kk) * ATT_KS + d8 * 16) = o;
            } else {
                LAS unsigned char* vb = lds + ATT_KBYTES + (kvh_s * 64 + d8 * 8) * ATT_VS + kk * 2;
                *(LAS unsigned short*)(vb + 0 * ATT_VS) = (unsigned short)(raw.x & 0xffffu); *(LAS unsigned short*)(vb + 1 * ATT_VS) = (unsigned short)(raw.x >> 16);
                *(LAS unsigned short*)(vb + 2 * ATT_VS) = (unsigned short)(raw.y & 0xffffu); *(LAS unsigned short*)(vb + 3 * ATT_VS) = (unsigned short)(raw.y >> 16);
                *(LAS unsigned short*)(vb + 4 * ATT_VS) = (unsigned short)(raw.z & 0xffffu); *(LAS unsigned short*)(vb + 5 * ATT_VS) = (unsigned short)(raw.z >> 16);
                *(LAS unsigned short*)(vb + 6 * ATT_VS) = (unsigned short)(raw.w & 0xffffu); *(LAS unsigned short*)(vb + 7 * ATT_VS) = (unsigned short)(raw.w >> 16);
            }
        }
        __syncthreads();
        for (int qt = 0; qt < 2; ++qt) {
            const int tokq = tok0 + 32 * qt + qq;
            const bf16_t* qp = z + (size_t)tokq * MIXIN + 512 + h * 64 + 8 * hh;
            u32x4 qraw[4];
#pragma unroll
            for (int s = 0; s < 4; ++s) qraw[s] = *(const u32x4*)(qp + 16 * s);
            float ssq = 0.f;
#pragma unroll
            for (int s = 0; s < 4; ++s) { const float f[8] = {bf_lo(qraw[s].x), bf_hi(qraw[s].x), bf_lo(qraw[s].y), bf_hi(qraw[s].y), bf_lo(qraw[s].z), bf_hi(qraw[s].z), bf_lo(qraw[s].w), bf_hi(qraw[s].w)};
#pragma unroll
                for (int e = 0; e < 8; ++e) ssq += f[e] * f[e]; }
            ssq += __shfl_xor(ssq, 32);
            const float qs = fast_rsq(ssq * (1.0f / 64.0f) + EPS) * (0.125f * LOG2E);
            bf16x8 Qf[4];
#pragma unroll
            for (int s = 0; s < 4; ++s) { u32x4 o;
                o.x = pk2(bf_lo(qraw[s].x) * qs, bf_hi(qraw[s].x) * qs); o.y = pk2(bf_lo(qraw[s].y) * qs, bf_hi(qraw[s].y) * qs);
                o.z = pk2(bf_lo(qraw[s].z) * qs, bf_hi(qraw[s].z) * qs); o.w = pk2(bf_lo(qraw[s].w) * qs, bf_hi(qraw[s].w) * qs);
                Qf[s] = __builtin_bit_cast(bf16x8, o); }
            f32x16 S[5];
#pragma unroll
            for (int tt = 0; tt < 5; ++tt) {
#pragma unroll
                for (int i = 0; i < 16; ++i) S[tt][i] = 0.f;
#pragma unroll
                for (int s = 0; s < 4; ++s) { const bf16x8 Kf = *(const LAS bf16x8*)(lds + (kvh * 192 + 32 * qt + 32 * tt + qq) * ATT_KS + (16 * s + 8 * hh) * 2);
                    S[tt] = __builtin_amdgcn_mfma_f32_32x32x16_bf16(Kf, Qf[s], S[tt], 0, 0, 0); }
            }
            float mx = -1e30f;
#pragma unroll
            for (int tt = 0; tt < 5; ++tt)
#pragma unroll
                for (int i = 0; i < 16; ++i) { const int jj = 32 * tt + (i & 3) + 8 * (i >> 2) + 4 * hh;
                    const bool valid = (jj > qq) && (jj <= qq + 128) && ((n > 0) || (64 * half + 32 * qt + jj >= 128));
                    const float v = valid ? S[tt][i] : -1e30f; S[tt][i] = v; mx = fmaxf(mx, v); }
            mx = fmaxf(mx, __shfl_xor(mx, 32)); mx = fmaxf(mx, sink2);
            float sum = 0.f;
#pragma unroll
            for (int tt = 0; tt < 5; ++tt)
#pragma unroll
                for (int i = 0; i < 16; ++i) { const float e = fast_exp2(S[tt][i] - mx); S[tt][i] = e; sum += e; }
            sum += __shfl_xor(sum, 32);
            const float inv = fast_rcp(sum + fast_exp2(sink2 - mx));
            f32x16 O[2];
#pragma unroll
            for (int dt = 0; dt < 2; ++dt)
#pragma unroll
                for (int i = 0; i < 16; ++i) O[dt][i] = 0.f;
#pragma unroll
            for (int tt = 0; tt < 5; ++tt)
#pragma unroll
                for (int c2 = 0; c2 < 2; ++c2) { u32x4 pw;
                    pw.x = pk2(S[tt][8 * c2 + 0], S[tt][8 * c2 + 1]); pw.y = pk2(S[tt][8 * c2 + 2], S[tt][8 * c2 + 3]);
                    pw.z = pk2(S[tt][8 * c2 + 4], S[tt][8 * c2 + 5]); pw.w = pk2(S[tt][8 * c2 + 6], S[tt][8 * c2 + 7]);
                    const bf16x8 Pf = __builtin_bit_cast(bf16x8, pw);
#pragma unroll
                    for (int dt = 0; dt < 2; ++dt) { const LAS unsigned char* vp = lds + ATT_KBYTES + (kvh * 64 + 32 * dt + qq) * ATT_VS + (32 * qt + 32 * tt + 16 * c2 + 4 * hh) * 2;
                        const u32x2 v0 = *(const LAS u32x2*)vp, v1 = *(const LAS u32x2*)(vp + 16); const u32x4 vv = {v0.x, v0.y, v1.x, v1.y};
                        O[dt] = __builtin_amdgcn_mfma_f32_32x32x16_bf16(__builtin_bit_cast(bf16x8, vv), Pf, O[dt], 0, 0, 0); } }
            float sq = 0.f;
#pragma unroll
            for (int dt = 0; dt < 2; ++dt)
#pragma unroll
                for (int i = 0; i < 16; ++i) { const float v = O[dt][i] * inv; O[dt][i] = v; sq += v * v; }
            sq += __shfl_xor(sq, 32);
            if (hh == 0) atomic_addf(ssa + tokq, sq);
            bf16_t* op = merged + (size_t)tokq * DM + 512 + h * 64 + 4 * hh;
#pragma unroll
            for (int dt = 0; dt < 2; ++dt)
#pragma unroll
                for (int i4 = 0; i4 < 4; ++i4) { u32x2 w; w.x = pk2(O[dt][4 * i4 + 0], O[dt][4 * i4 + 1]); w.y = pk2(O[dt][4 * i4 + 2], O[dt][4 * i4 + 3]);
                    *(u32x2*)(op + 32 * dt + 8 * i4) = w; }
        }
        __syncthreads();
    }
}

__global__ void __launch_bounds__(512, 2) mk_fwd(Args a) {
    extern __shared__ __attribute__((aligned(16))) unsigned char lds_raw[];
    LAS unsigned char* lds = (LAS unsigned char*)lds_raw;
    cg::grid_group grid = cg::this_grid();
    const int G = gridDim.x, lo = a.ph_lo, hi = a.ph_hi;
    unsigned char* ws = a.ws;
    float* ss0 = (float*)(ws + WS_SS); float* ss1 = ss0 + T; float* ssp = ss0 + 2 * T; float* ssa = ss0 + 3 * T; float* ss2 = ss0 + 4 * T; float* ss3 = ss0 + 5 * T;
    bf16_t* XB = (bf16_t*)(ws + WS_XB); bf16_t* PB = (bf16_t*)(ws + WS_PB); bf16_t* PP = (bf16_t*)(ws + WS_PP); bf16_t* ACT = (bf16_t*)(ws + WS_ACT);
    bf16_t* Z = (bf16_t*)(ws + WS_Z); bf16_t* DP = (bf16_t*)(ws + WS_DP); bf16_t* MG = (bf16_t*)(ws + WS_MG);
    float* X = a.out;
#ifndef PHMASK
#define PHMASK 0x3ff
#endif
#define IN(k) (((PHMASK >> (k)) & 1) && lo <= (k) && (k) < hi)
#define SEAM(k) do { if (IN(k) && IN((k) + 1)) grid.sync(); } while (0)
    if (IN(0)) { p0_prep(a, lds, G); __syncthreads(); }
    SEAM(0);
    if (IN(1)) { pg8::Gemm g{XB, (const bf16_t*)(ws + WS_WGU1), T, NGU, DM}; pg8::StaticOrder S; S.init(T, NGU, G, (int)blockIdx.x);
        pg8::EpiSwiGLU E{ACT, ss0}; pg8::gemm_phase<pg8::EpiSwiGLU, pg8::StaticOrder>(lds, g, S, E); }
    SEAM(1);
    if (IN(2)) { pg8::Gemm g{ACT, (const bf16_t*)(ws + WS_WD1), T, DM, FF}; pg8::StaticOrder S; S.init(T, DM, G, (int)blockIdx.x);
        pg8::EpiResid<false> E{a.in[0], X, XB, ss1, 0.5f, nullptr, nullptr}; pg8::gemm_phase<pg8::EpiResid<false>, pg8::StaticOrder>(lds, g, S, E); }
    SEAM(2);
    if (IN(3)) { pg8::Gemm g{XB, (const bf16_t*)(ws + WS_WIN), T, MIXIN, DM}; pg8::StaticOrder S; S.init(T, MIXIN, G, (int)blockIdx.x);
        pg8::EpiScaleBf16 E{Z, MIXIN, ss1}; pg8::gemm_phase<pg8::EpiScaleBf16, pg8::StaticOrder>(lds, g, S, E); }
    SEAM(3);
    if (IN(4)) { p4_pool_diff(Z, DP, G); }
    SEAM(4);
    if (IN(5)) { p5_attention(lds, Z, MG, ssa, a.in[10], a.in[11], a.in[12], G);
        pg8::Gemm g{DP, (const bf16_t*)(ws + WS_WPOOL), T, POOLW, POOLW}; pg8::StaticOrder S; S.init(T, POOLW, G, (int)blockIdx.x);
        pg8::EpiPool E{MG, a.in[9], ssp}; pg8::gemm_phase<pg8::EpiPool, pg8::StaticOrder>(lds, g, S, E); }
    SEAM(5);
    if (IN(6)) { pg8::Gemm g{MG, (const bf16_t*)(ws + WS_WOUT), T, DM, DM}; pg8::StaticOrder S; S.init(T, DM, G, (int)blockIdx.x);
        pg8::EpiResid<true> E{X, X, XB, ss2, 1.0f, ssp, ssa}; pg8::gemm_phase<pg8::EpiResid<true>, pg8::StaticOrder>(lds, g, S, E); }
    SEAM(6);
    if (IN(7)) { pg8::Gemm g{XB, (const bf16_t*)(ws + WS_WGU2), T, NGU, DM}; pg8::StaticOrder S; S.init(T, NGU, G, (int)blockIdx.x);
        pg8::EpiSwiGLU E{ACT, ss2}; pg8::gemm_phase<pg8::EpiSwiGLU, pg8::StaticOrder>(lds, g, S, E); }
    SEAM(7);
    if (IN(8)) { pg8::Gemm g{ACT, (const bf16_t*)(ws + WS_WD2), T, DM, FF}; pg8::StaticOrder S; S.init(T, DM, G, (int)blockIdx.x);
        pg8::EpiResid<false> E{X, X, XB, ss3, 0.5f, nullptr, nullptr}; pg8::gemm_phase<pg8::EpiResid<false>, pg8::StaticOrder>(lds, g, S, E); }
    SEAM(8);
    if (IN(9)) {
        { pg8::Gemm g{PB, (const bf16_t*)(ws + WS_WPP), T, DM, PLE}; pg8::StaticOrder S; S.init(T, DM, G, (int)blockIdx.x);
          pg8::EpiScaleBf16 E{PP, DM, nullptr}; pg8::gemm_phase<pg8::EpiScaleBf16, pg8::StaticOrder>(lds, g, S, E); }
        { pg8::Gemm g{XB, (const bf16_t*)(ws + WS_WPG), T, DM, DM}; pg8::StaticOrder S; S.init(T, DM, G, (int)blockIdx.x);
          pg8::EpiFinal E{X, PP, ss3}; pg8::gemm_phase<pg8::EpiFinal, pg8::StaticOrder>(lds, g, S, E); }
    }
#undef IN
#undef SEAM
}

extern "C" void kernel_launch(void* const* d_in, const int* in_sizes, int n_in, void* d_out, int out_size, void* d_ws, size_t ws_size, hipStream_t stream) {
    static int grid = 0;
    if (grid == 0) {
        if (n_in != 23 || out_size != T * DM || ws_size < WS_END) { fprintf(stderr, "kernel_launch: unexpected shapes (n_in %d, out %d, ws %zu)\n", n_in, out_size, ws_size); grid = -1; return; }
        int dev = 0, cus = 0, per_cu = 0;
        (void)hipGetDevice(&dev); (void)hipDeviceGetAttribute(&cus, hipDeviceAttributeMultiprocessorCount, dev);
        if (hipFuncSetAttribute((const void*)mk_fwd, hipFuncAttributeMaxDynamicSharedMemorySize, LDS_BYTES) != hipSuccess) { fprintf(stderr, "kernel_launch: hipFuncSetAttribute failed\n"); grid = -1; return; }
        if (hipOccupancyMaxActiveBlocksPerMultiprocessor(&per_cu, (const void*)mk_fwd, 512, LDS_BYTES) != hipSuccess || per_cu < 1) { fprintf(stderr, "kernel_launch: occupancy query gave %d\n", per_cu); per_cu = 1; }
        (void)hipGetLastError();
        grid = cus * per_cu;
        fprintf(stderr, "kernel_launch: grid %d (cus %d x %d)\n", grid, cus, per_cu);
    }
    if (grid < 0) return;
    Args a{};
    for (int i = 0; i < 23; ++i) a.in[i] = (const float*)d_in[i];
    a.out = (float*)d_out; a.ws = (unsigned char*)d_ws;
#if MK_N_LAUNCHES == 1
    a.ph_lo = 0; a.ph_hi = NPHASE;
    void* args[] = {&a};
    hipError_t e = hipLaunchCooperativeKernel((const void*)mk_fwd, dim3(grid), dim3(512), args, LDS_BYTES, stream);
    if (e != hipSuccess) fprintf(stderr, "kernel_launch: cooperative launch failed: %s (grid %d)\n", hipGetErrorString(e), grid);
#else
    for (int p = 0; p < NPHASE; ++p) { a.ph_lo = p; a.ph_hi = p + 1; hipLaunchKernelGGL(mk_fwd, dim3(grid), dim3(512), LDS_BYTES, stream, a); }
#endif
}
```

```cpp
#include <hip/hip_runtime.h>
#include <hip/hip_cooperative_groups.h>
#include <cstdio>
#include <cstdint>
namespace cg = cooperative_groups;

#ifndef MK_N_LAUNCHES
#define MK_N_LAUNCHES 1
#endif

#define LAS __attribute__((address_space(3)))
typedef unsigned short bf16_t;
typedef short bf16x8 __attribute__((ext_vector_type(8)));
typedef float f32x4 __attribute__((ext_vector_type(4)));
typedef float f32x2 __attribute__((ext_vector_type(2)));
typedef float f32x16 __attribute__((ext_vector_type(16)));
typedef unsigned u32x4 __attribute__((ext_vector_type(4)));
typedef unsigned u32x2 __attribute__((ext_vector_type(2)));
typedef __bf16 bf16x2_t __attribute__((ext_vector_type(2)));

__device__ __forceinline__ unsigned pk2(float lo, float hi) { f32x2 v = {lo, hi}; bf16x2_t b = __builtin_convertvector(v, bf16x2_t); return __builtin_bit_cast(unsigned, b); }
__device__ __forceinline__ float bf_lo(unsigned w) { return __builtin_bit_cast(float, w << 16); }
__device__ __forceinline__ float bf_hi(unsigned w) { return __builtin_bit_cast(float, w & 0xffff0000u); }
__device__ __forceinline__ float fast_exp2(float x) { return __builtin_amdgcn_exp2f(x); }
__device__ __forceinline__ float fast_rcp(float x) { return __builtin_amdgcn_rcpf(x); }
__device__ __forceinline__ float fast_rsq(float x) { return __builtin_amdgcn_rsqf(x); }
__device__ __forceinline__ void atomic_addf(float* p, float v) { __hip_atomic_fetch_add(p, v, __ATOMIC_RELAXED, __HIP_MEMORY_SCOPE_AGENT); }

constexpr int T = 65536, DM = 1024, FF = 2816, NGU = 2 * FF, MIXIN = 1280, SEQ = 2048, PLE = 256, POOLW = 512;
constexpr float EPS = 1e-6f, LOG2E = 1.4426950408889634f;

namespace pg8 {
constexpr int BM = 256, BK = 64, HALF = 128, HTB = HALF * BK * 2, STAGE_BYTES = 8 * HTB, NXCD = 8, WGM = 8;
__host__ __device__ __forceinline__ int lds_byte(int r, int c) { const int st = (r >> 4) * 2 + (c >> 5), rr = r & 15, cc = c & 31, ob = rr * 64 + cc * 2; return st * 1024 + (ob ^ (((ob >> 9) & 1) << 5)); }
__host__ __device__ __forceinline__ void stage_rc(int b, int& R, int& C) { const int st = b / 1024, sb = b % 1024, swz = sb ^ (((sb >> 9) & 1) << 5); R = (st >> 1) * 16 + swz / 64; C = (st & 1) * 32 + (swz % 64) / 2; }
__host__ __device__ __forceinline__ int perm32(int rho) { const int n = rho >> 4, i = rho & 15; return 8 * (i >> 2) + 4 * n + (i & 3); }

struct Unit { int pm, pn; };
struct Gemm { const bf16_t* A; const bf16_t* Bt; int M, N, K, KL, kdiag; };

struct StaticOrder {
    int nM, nN, nwg, G, c;
    __host__ __device__ void init(int M, int N, int G_, int c_) { nM = M / BM; nN = N / BM; nwg = nM * nN; G = G_; c = c_; }
    __host__ __device__ bool next(int i, Unit& u) const {
        const long L = (long)i * G + c; if (L >= nwg) return false;
        int wgid = (int)L; { const int q = nwg / NXCD, r = nwg % NXCD, xcd = wgid % NXCD, off = wgid / NXCD; wgid = (xcd < r ? xcd * (q + 1) : r * (q + 1) + (xcd - r) * q) + off; }
        const int nig = WGM * nN, gid = wgid / nig, fm = gid * WGM, gsz = (nM - fm) < WGM ? (nM - fm) : WGM;
        u.pm = fm + ((wgid % nig) % gsz); u.pn = (wgid % nig) / gsz; return true;
    }
};

constexpr int GS = 32;
constexpr int GPM = 4;
struct GroupOrder {
    int nN, U, p, r;
    __host__ __device__ void init(int N, int p_, int r_) { nN = N / BM; U = GS * nN; p = p_; r = r_; }
    __host__ __device__ bool next(int i, Unit& u) const {
        const int L = i * GS + r; if (L >= U) return false;
        const int nig = GPM * nN, gid = L / nig, rem = L - gid * nig; u.pm = GS * p + GPM * gid + (rem % GPM); u.pn = rem / GPM; return true;
    }
};

typedef f32x4 Acc[2][2][4][2];

__device__ __forceinline__ u32x4 pack8(const f32x4 a, const f32x4 b) { u32x4 w; w.x = pk2(a[0], a[1]); w.y = pk2(a[2], a[3]); w.z = pk2(b[0], b[1]); w.w = pk2(b[2], b[3]); return w; }
__device__ __forceinline__ float sq4(const f32x4 a) { return (a[0] * a[0] + a[1] * a[1]) + (a[2] * a[2] + a[3] * a[3]); }

struct EpiSwiGLU {
    static constexpr bool PERM = true, MID = false, ZFIRST = true;
    bf16_t* O; const float* ss;
    __device__ __forceinline__ void mid(Acc&, const Unit&, int, int) const {}
    __device__ __forceinline__ void operator()(const Acc& acc, const Unit& u, int wr, int wc, int fr, int fq) const {
        asm volatile("" : "+v"(fr), "+v"(fq));
        const int row0 = u.pm * BM + wr * 64 + fr, col0 = u.pn * 128 + wc * 32 + 8 * fq;
#pragma unroll
        for (int ai = 0; ai < 2; ++ai)
#pragma unroll
            for (int m = 0; m < 4; ++m) {
                const int row = row0 + ai * HALF + m * 16; const float var = ss[row] * (1.0f / DM) + EPS; const float r = fast_rsq(var); const float nr = -LOG2E * r;
                f32x4 o[2];
#pragma unroll
                for (int n = 0; n < 2; ++n) { const f32x4 t = acc[ai][0][m][n] * nr, pr = acc[ai][0][m][n] * acc[ai][1][m][n]; f32x4 d;
#pragma unroll
                    for (int j = 0; j < 4; ++j) d[j] = fast_rcp(__builtin_fmaf(fast_exp2(t[j]), var, var));
                    o[n] = pr * d; }
                __builtin_nontemporal_store(pack8(o[0], o[1]), (u32x4*)(O + (unsigned)(row * FF + col0)));
            }
    }
};
template <bool ROWSCALE, bool XF32> struct EpiResid {
    static constexpr bool PERM = true, MID = ROWSCALE, ZFIRST = !ROWSCALE;
    const float* xin; bf16_t* xb; float* ss_out; float alpha; const float* ssp; const float* ssa;
    __device__ __forceinline__ void mid(Acc& acc, const Unit& u, int wr, int fr) const {
        asm volatile("" : "+v"(fr));
        const int row0 = u.pm * BM + wr * 64 + fr;
#pragma unroll
        for (int ai = 0; ai < 2; ++ai)
#pragma unroll
            for (int m = 0; m < 4; ++m) { const int row = row0 + ai * HALF + m * 16;
                const float vp = ssp[row] * (1.0f / 512.0f) + EPS, va = ssa[row] * (1.0f / 512.0f) + EPS; const float ratio = __builtin_sqrtf(va * fast_rcp(vp));
#pragma unroll
                for (int bj = 0; bj < 2; ++bj)
#pragma unroll
                    for (int n = 0; n < 2; ++n) acc[ai][bj][m][n] *= ratio; }
    }
    __device__ __forceinline__ void operator()(const Acc& acc, const Unit& u, int wr, int wc, int fr, int fq) const {
        asm volatile("" : "+v"(fr), "+v"(fq));
        const int row0 = u.pm * BM + wr * 64 + fr, col0 = u.pn * BM + wc * 32 + 8 * fq;
#pragma unroll
        for (int ai = 0; ai < 2; ++ai) {
            f32x4 xv[4][2][2]; float rsv[4];
#pragma unroll
            for (int m = 0; m < 4; ++m) { const int row = row0 + ai * HALF + m * 16;
                rsv[m] = ROWSCALE ? ssa[row] : 0.f;
#pragma unroll
                for (int bj = 0; bj < 2; ++bj) { const unsigned off = (unsigned)(row * DM + col0 + bj * HALF);
                    if constexpr (XF32) { xv[m][bj][0] = __builtin_nontemporal_load((const f32x4*)(xin + off)); xv[m][bj][1] = __builtin_nontemporal_load((const f32x4*)(xin + off + 4)); }
                    else { const u32x4 w = *(const u32x4*)(xb + off); xv[m][bj][0] = (f32x4){bf_lo(w.x), bf_hi(w.x), bf_lo(w.y), bf_hi(w.y)}; xv[m][bj][1] = (f32x4){bf_lo(w.z), bf_hi(w.z), bf_lo(w.w), bf_hi(w.w)}; } } }
#pragma unroll
            for (int m = 0; m < 4; ++m) { const int row = row0 + ai * HALF + m * 16;
                float rs = alpha; if (ROWSCALE) rs *= fast_rsq(rsv[m] * (1.0f / 512.0f) + EPS);
                float s = 0.f;
#pragma unroll
                for (int bj = 0; bj < 2; ++bj) { const unsigned off = (unsigned)(row * DM + col0 + bj * HALF);
                    const f32x4 o0 = xv[m][bj][0] + rs * acc[ai][bj][m][0], o1 = xv[m][bj][1] + rs * acc[ai][bj][m][1];
                    *(u32x4*)(xb + off) = pack8(o0, o1);
                    s += sq4(o0) + sq4(o1); }
                s += __shfl_xor(s, 16); s += __shfl_xor(s, 32);
                if (fq == 0) atomic_addf(ss_out + row, s); }
            asm volatile("" ::: "memory");
        }
    }
};
template <bool ZF_> struct EpiScaleBf16 {
    static constexpr bool PERM = true, MID = false, ZFIRST = ZF_;
    bf16_t* O; int ldc; const float* ss;
    __device__ __forceinline__ void mid(Acc&, const Unit&, int, int) const {}
    __device__ __forceinline__ void operator()(const Acc& acc, const Unit& u, int wr, int wc, int fr, int fq) const {
        asm volatile("" : "+v"(fr), "+v"(fq));
        const int row0 = u.pm * BM + wr * 64 + fr, col0 = u.pn * BM + wc * 32 + 8 * fq;
#pragma unroll
        for (int ai = 0; ai < 2; ++ai)
#pragma unroll
            for (int m = 0; m < 4; ++m) { const int row = row0 + ai * HALF + m * 16; const float r = ss ? fast_rsq(ss[row] * (1.0f / DM) + EPS) : 1.0f;
#pragma unroll
                for (int bj = 0; bj < 2; ++bj) *(u32x4*)(O + (unsigned)(row * ldc + col0 + bj * HALF)) = pack8(acc[ai][bj][m][0] * r, acc[ai][bj][m][1] * r); }
    }
};
struct EpiPool {
    static constexpr bool PERM = true, MID = false, ZFIRST = false;
    bf16_t* O; const float* pscale; float* ss_out;
    __device__ __forceinline__ void mid(Acc&, const Unit&, int, int) const {}
    __device__ __forceinline__ void operator()(const Acc& acc, const Unit& u, int wr, int wc, int fr, int fq) const {
        asm volatile("" : "+v"(fr), "+v"(fq));
        const int row0 = u.pm * BM + wr * 64 + fr, col0 = u.pn * BM + wc * 32 + 8 * fq;
        f32x4 ps[2][2];
#pragma unroll
        for (int bj = 0; bj < 2; ++bj)
#pragma unroll
            for (int n = 0; n < 2; ++n) ps[bj][n] = *(const f32x4*)(pscale + col0 + bj * HALF + 4 * n);
#pragma unroll
        for (int ai = 0; ai < 2; ++ai)
#pragma unroll
            for (int m = 0; m < 4; ++m) { const int row = row0 + ai * HALF + m * 16; float s = 0.f;
#pragma unroll
                for (int bj = 0; bj < 2; ++bj) { const f32x4 o0 = acc[ai][bj][m][0] * ps[bj][0], o1 = acc[ai][bj][m][1] * ps[bj][1];
                    *(u32x4*)(O + (unsigned)(row * DM + col0 + bj * HALF)) = pack8(o0, o1); s += sq4(o0) + sq4(o1); }
                s += __shfl_xor(s, 16); s += __shfl_xor(s, 32);
                if (fq == 0) atomic_addf(ss_out + row, s); }
    }
};
struct EpiFinal {
    static constexpr bool PERM = true, MID = false, ZFIRST = true;
    float* out; const bf16_t* xb; const bf16_t* P; const float* ss;
    __device__ __forceinline__ void mid(Acc&, const Unit&, int, int) const {}
    __device__ __forceinline__ void operator()(const Acc& acc, const Unit& u, int wr, int wc, int fr, int fq) const {
        asm volatile("" : "+v"(fr), "+v"(fq));
        const int row0 = u.pm * BM + wr * 64 + fr, col0 = u.pn * BM + wc * 32 + 8 * fq;
#pragma unroll
        for (int ai = 0; ai < 2; ++ai) {
            u32x4 xw[4][2], pv[4][2]; float rv[4];
#pragma unroll
            for (int m = 0; m < 4; ++m) { const int row = row0 + ai * HALF + m * 16; rv[m] = ss[row];
#pragma unroll
                for (int bj = 0; bj < 2; ++bj) { const unsigned off = (unsigned)(row * DM + col0 + bj * HALF); xw[m][bj] = *(const u32x4*)(xb + off); pv[m][bj] = *(const u32x4*)(P + off); } }
#pragma unroll
            for (int m = 0; m < 4; ++m) { const int row = row0 + ai * HALF + m * 16; const float r = -LOG2E * fast_rsq(rv[m] * (1.0f / DM) + EPS);
#pragma unroll
                for (int bj = 0; bj < 2; ++bj) { const unsigned off = (unsigned)(row * DM + col0 + bj * HALF); const u32x4 pw = pv[m][bj], w = xw[m][bj];
                    const f32x4 p0 = {bf_lo(pw.x), bf_hi(pw.x), bf_lo(pw.y), bf_hi(pw.y)}, p1 = {bf_lo(pw.z), bf_hi(pw.z), bf_lo(pw.w), bf_hi(pw.w)};
                    const f32x4 x0 = {bf_lo(w.x), bf_hi(w.x), bf_lo(w.y), bf_hi(w.y)}, x1 = {bf_lo(w.z), bf_hi(w.z), bf_lo(w.w), bf_hi(w.w)};
                    f32x4 o0, o1;
#pragma unroll
                    for (int j = 0; j < 4; ++j) { o0[j] = x0[j] + p0[j] * fast_rcp(1.0f + fast_exp2(r * acc[ai][bj][m][0][j])); o1[j] = x1[j] + p1[j] * fast_rcp(1.0f + fast_exp2(r * acc[ai][bj][m][1][j])); }
                    __builtin_nontemporal_store(o0, (f32x4*)(out + off)); __builtin_nontemporal_store(o1, (f32x4*)(out + off + 4)); } }
            asm volatile("" ::: "memory"); }
    }
};

template <class Epi, class Sched, bool ALIGN_EPI = true, bool SP2 = true>
__device__ __forceinline__ void gemm_phase(LAS unsigned char* lds, const Gemm g, const Sched& S, const Epi& E) {
    int tid_ = threadIdx.x; asm volatile("" : "+v"(tid_));
    const int tid = tid_, wid = __builtin_amdgcn_readfirstlane(tid >> 6), lane = tid & 63, wr = wid >> 2, wc = wid & 3, fr = lane & 15, fq = lane >> 4;
    const int K = g.K, nt = g.KL / BK;
    unsigned voffA[2], voffB[2];
#pragma unroll
    for (int i = 0; i < 2; ++i) { int R, C; stage_rc(tid * 16 + i * 8192, R, C); const int Rb = Epi::PERM ? ((R & ~31) + perm32(R & 31)) : R;
        voffA[i] = (unsigned)(R * K + C) * 2u; voffB[i] = (unsigned)(Rb * K + C) * 2u; }
    const size_t kstep = (size_t)(BK * 2);
    const size_t hstep = (size_t)HALF * K * 2;
    const size_t tstep = 2 * hstep;
    const unsigned ldsw = (unsigned)wid * 1024u;
    const int aoff = lds_byte(wr * 64 + fr, fq * 8), boff = lds_byte(wc * 32 + fr, fq * 8);
#define PG8_SA(b, h) (((b) * 2 + (h)) * HTB)
#define PG8_SB(b, h) ((4 + (b) * 2 + (h)) * HTB)
#define PG8_STAGE(bufoff, gbase, voff) do { _Pragma("unroll") for (int _i = 0; _i < 2; ++_i) \
        __builtin_amdgcn_global_load_lds((const unsigned*)((const char*)(gbase) + (voff)[_i]), (LAS unsigned*)(lds + (bufoff) + ldsw + _i * 8192), 16, 0, 0); } while (0)
#define PG8_LDA(dst, b, h) do { _Pragma("unroll") for (int m = 0; m < 4; ++m) _Pragma("unroll") for (int k = 0; k < 2; ++k) dst[m][k] = *(const LAS bf16x8*)(lds + PG8_SA(b, h) + aoff + m * 2048 + k * 1024); } while (0)
#define PG8_LDB(dst, b, h) do { _Pragma("unroll") for (int n = 0; n < 2; ++n) _Pragma("unroll") for (int k = 0; k < 2; ++k) dst[n][k] = *(const LAS bf16x8*)(lds + PG8_SB(b, h) + boff + n * 2048 + k * 1024); } while (0)
#define PG8_MMA(ai, bj, At, Bt) do { __builtin_amdgcn_s_setprio(1); _Pragma("unroll") for (int m = 0; m < 4; ++m) _Pragma("unroll") for (int n = 0; n < 2; ++n) _Pragma("unroll") for (int k = 0; k < 2; ++k) \
        acc[ai][bj][m][n] = __builtin_amdgcn_mfma_f32_16x16x32_bf16(Bt[n][k], At[m][k], acc[ai][bj][m][n], 0, 0, 0); __builtin_amdgcn_s_setprio(0); } while (0)
#define PG8_MMAZ(ai, bj, At, Bt) do { __builtin_amdgcn_s_setprio(1); _Pragma("unroll") for (int m = 0; m < 4; ++m) _Pragma("unroll") for (int n = 0; n < 2; ++n) { \
        acc[ai][bj][m][n] = __builtin_amdgcn_mfma_f32_16x16x32_bf16(Bt[n][0], At[m][0], (f32x4){0.f, 0.f, 0.f, 0.f}, 0, 0, 0); \
        acc[ai][bj][m][n] = __builtin_amdgcn_mfma_f32_16x16x32_bf16(Bt[n][1], At[m][1], acc[ai][bj][m][n], 0, 0, 0); } __builtin_amdgcn_s_setprio(0); } while (0)
#define PG8_WAIT_V(n) asm volatile("s_waitcnt vmcnt(" #n ")" ::: "memory")
#define PG8_WAIT_L(n) asm volatile("s_waitcnt lgkmcnt(" #n ")" ::: "memory")
#define PG8_BAR __builtin_amdgcn_s_barrier()
#define PG8_SCHED __builtin_amdgcn_sched_barrier(0)
    Unit cur, nxt; int ui = 0;
    if (!S.next(0, cur)) return;
    constexpr bool ZF = SP2 && Epi::ZFIRST;
    Acc acc;
    if constexpr (!ZF) {
#pragma unroll
    for (int a = 0; a < 2; ++a)
#pragma unroll
        for (int b = 0; b < 2; ++b)
#pragma unroll
            for (int m = 0; m < 4; ++m)
#pragma unroll
                for (int n = 0; n < 2; ++n) acc[a][b][m][n] = (f32x4){0.f, 0.f, 0.f, 0.f};
    }
    bf16x8 At[4][2], B0[2][2], B1[2][2];
    const char* cA = (const char*)g.A + (size_t)cur.pm * tstep; const char* cB = (const char*)g.Bt + (size_t)cur.pn * tstep;
    if constexpr (SP2) {
        PG8_STAGE(PG8_SB(0, 0), cB, voffB); PG8_STAGE(PG8_SB(0, 1), cB + hstep, voffB); PG8_STAGE(PG8_SA(0, 0), cA, voffA); PG8_STAGE(PG8_SA(0, 1), cA + hstep, voffA);
        if (wr == 1) PG8_BAR;
        PG8_WAIT_V(2); PG8_BAR;
        PG8_STAGE(PG8_SB(1, 0), cB + kstep, voffB); PG8_STAGE(PG8_SA(1, 0), cA + kstep, voffA); PG8_STAGE(PG8_SB(1, 1), cB + hstep + kstep, voffB);
        PG8_WAIT_V(6); PG8_BAR;
    } else {
        PG8_STAGE(PG8_SB(0, 0), cB, voffB); PG8_STAGE(PG8_SA(0, 0), cA, voffA); PG8_STAGE(PG8_SB(0, 1), cB + hstep, voffB); PG8_STAGE(PG8_SA(0, 1), cA + hstep, voffA);
        if (wr == 1) PG8_BAR;
        PG8_WAIT_V(4); PG8_BAR;
        PG8_STAGE(PG8_SB(1, 0), cB + kstep, voffB); PG8_STAGE(PG8_SA(1, 0), cA + kstep, voffA); PG8_STAGE(PG8_SB(1, 1), cB + hstep + kstep, voffB);
        PG8_WAIT_V(6); PG8_BAR;
    }
    for (;;) {
        const bool has_next = S.next(ui + 1, nxt);
        const char* nA = has_next ? (const char*)g.A + (size_t)nxt.pm * tstep : cA; const char* nB = has_next ? (const char*)g.Bt + (size_t)nxt.pn * tstep : cB;
        for (int t = 0; t < nt; t += 2) {
            const bool last = (t == nt - 2);
            const char* a1 = cA + (size_t)(t + 1) * kstep;
            const char* a2 = last ? nA : cA + (size_t)(t + 2) * kstep; const char* b2 = last ? nB : cB + (size_t)(t + 2) * kstep;
            const char* a3 = a2 + kstep; const char* b3 = b2 + kstep;
            if constexpr (Epi::MID) { if (t == (nt >> 1)) { int t2 = threadIdx.x; asm volatile("" : "+v"(t2)); E.mid(acc, cur, wr, t2 & 15); } }
            if constexpr (SP2) {
            if (ZF && t == 0) {
            PG8_LDB(B0, 0, 0); PG8_LDB(B1, 0, 1); PG8_SCHED; PG8_LDA(At, 0, 0); PG8_STAGE(PG8_SA(1, 1), a1 + hstep, voffA);
            PG8_WAIT_V(8); PG8_WAIT_L(0); PG8_BAR; PG8_MMAZ(0, 0, At, B0); PG8_MMAZ(0, 1, At, B1); PG8_BAR; PG8_SCHED;
            PG8_LDA(At, 0, 1); PG8_STAGE(PG8_SB(0, 0), b2, voffB); PG8_STAGE(PG8_SB(0, 1), b2 + hstep, voffB); PG8_STAGE(PG8_SA(0, 0), a2, voffA);
            PG8_WAIT_V(8); PG8_WAIT_L(0); PG8_BAR; PG8_MMAZ(1, 0, At, B0); PG8_MMAZ(1, 1, At, B1); PG8_BAR; PG8_SCHED;
            } else {
            PG8_LDB(B0, 0, 0); PG8_LDB(B1, 0, 1); PG8_SCHED; PG8_LDA(At, 0, 0); PG8_STAGE(PG8_SA(1, 1), a1 + hstep, voffA);
            PG8_WAIT_V(8); PG8_WAIT_L(0); PG8_BAR; PG8_MMA(0, 0, At, B0); PG8_MMA(0, 1, At, B1); PG8_BAR; PG8_SCHED;
            PG8_LDA(At, 0, 1); PG8_STAGE(PG8_SB(0, 0), b2, voffB); PG8_STAGE(PG8_SB(0, 1), b2 + hstep, voffB); PG8_STAGE(PG8_SA(0, 0), a2, voffA);
            PG8_WAIT_V(8); PG8_WAIT_L(0); PG8_BAR; PG8_MMA(1, 0, At, B0); PG8_MMA(1, 1, At, B1); PG8_BAR; PG8_SCHED;
            }
            PG8_LDB(B0, 1, 0); PG8_LDB(B1, 1, 1); PG8_SCHED; PG8_LDA(At, 1, 0); PG8_STAGE(PG8_SA(0, 1), a2 + hstep, voffA);
            PG8_WAIT_V(8); PG8_WAIT_L(0); PG8_BAR; PG8_MMA(0, 0, At, B0); PG8_MMA(0, 1, At, B1); PG8_BAR; PG8_SCHED;
            PG8_LDA(At, 1, 1); PG8_STAGE(PG8_SB(1, 0), b3, voffB); PG8_STAGE(PG8_SB(1, 1), b3 + hstep, voffB); PG8_STAGE(PG8_SA(1, 0), a3, voffA);
            PG8_WAIT_V(8); PG8_WAIT_L(0); PG8_BAR; PG8_MMA(1, 0, At, B0); PG8_MMA(1, 1, At, B1); PG8_BAR; PG8_SCHED;
            } else {
            PG8_LDB(B0, 0, 0); PG8_SCHED; PG8_LDA(At, 0, 0); PG8_STAGE(PG8_SA(1, 1), a1 + hstep, voffA);
            PG8_WAIT_L(8); PG8_BAR; PG8_WAIT_L(0); PG8_MMA(0, 0, At, B0); PG8_BAR; PG8_SCHED;
            PG8_LDB(B1, 0, 1); PG8_STAGE(PG8_SB(0, 0), b2, voffB);
            PG8_BAR; PG8_WAIT_L(0); PG8_MMA(0, 1, At, B1); PG8_BAR;
            PG8_LDA(At, 0, 1); PG8_STAGE(PG8_SA(0, 0), a2, voffA);
            PG8_BAR; PG8_WAIT_L(0); PG8_MMA(1, 0, At, B0); PG8_BAR; PG8_SCHED;
            PG8_STAGE(PG8_SB(0, 1), b2 + hstep, voffB);
            PG8_WAIT_V(6); PG8_BAR; PG8_MMA(1, 1, At, B1); PG8_BAR;
            PG8_LDB(B0, 1, 0); PG8_SCHED; PG8_LDA(At, 1, 0); PG8_STAGE(PG8_SA(0, 1), a2 + hstep, voffA);
            PG8_WAIT_L(8); PG8_BAR; PG8_WAIT_L(0); PG8_MMA(0, 0, At, B0); PG8_BAR; PG8_SCHED;
            PG8_LDB(B1, 1, 1); PG8_STAGE(PG8_SB(1, 0), b3, voffB);
            PG8_BAR; PG8_WAIT_L(0); PG8_MMA(0, 1, At, B1); PG8_BAR;
            PG8_LDA(At, 1, 1); PG8_STAGE(PG8_SA(1, 0), a3, voffA);
            PG8_BAR; PG8_WAIT_L(0); PG8_MMA(1, 0, At, B0); PG8_BAR; PG8_SCHED;
            PG8_STAGE(PG8_SB(1, 1), b3 + hstep, voffB);
            PG8_WAIT_V(6); PG8_BAR; PG8_MMA(1, 1, At, B1); PG8_BAR;
            }
        }
        if constexpr (ALIGN_EPI) { if (wr == 0) PG8_BAR; }
        { int t2 = threadIdx.x; asm volatile("" : "+v"(t2)); E(acc, cur, wr, wc, t2 & 15, (t2 & 63) >> 4); }
        if (!has_next) break;
        if constexpr (!ZF) {
#pragma unroll
        for (int a = 0; a < 2; ++a)
#pragma unroll
            for (int b = 0; b < 2; ++b)
#pragma unroll
                for (int m = 0; m < 4; ++m)
#pragma unroll
                    for (int n = 0; n < 2; ++n) acc[a][b][m][n] = (f32x4){0.f, 0.f, 0.f, 0.f};
        }
        cur = nxt; cA = nA; cB = nB; ++ui;
        if constexpr (ALIGN_EPI) { if (wr == 1) PG8_BAR; }
    }
    PG8_WAIT_V(0);
    if constexpr (!ALIGN_EPI) { if (wr == 0) PG8_BAR; }
    PG8_BAR;
#undef PG8_SA
#undef PG8_SB
#undef PG8_STAGE
#undef PG8_LDA
#undef PG8_LDB
#undef PG8_MMA
#undef PG8_MMAZ
#undef PG8_WAIT_V
#undef PG8_WAIT_L
#undef PG8_BAR
#undef PG8_SCHED
}
}

constexpr size_t MiB = 1u << 20;
constexpr size_t WS_CTL = 1536 * 1024;
constexpr size_t WS_SS = 0;
constexpr size_t WS_WGU1 = 2 * MiB, WS_WD1 = 13 * MiB, WS_WGU2 = 19 * MiB, WS_WD2 = 30 * MiB, WS_WIN = 36 * MiB, WS_WOUT = 39 * MiB, WS_WPG = 41 * MiB, WS_WPP = 43 * MiB, WS_WPOOL = 44 * MiB;
constexpr size_t WS_XB = 48 * MiB;
constexpr size_t WS_PB = 176 * MiB;
constexpr size_t WS_PP = 208 * MiB;
constexpr size_t WS_ACT = 336 * MiB;
constexpr size_t WS_END = 688 * MiB;
static_assert((size_t)2048 * FF * 2 == 11 * MiB && (size_t)2048 * MIXIN * 2 == 5 * MiB && (size_t)2048 * POOLW * 2 == 2 * MiB && (size_t)2048 * DM * 2 == 4 * MiB, "per-pipeline slab map");
constexpr int LDS_BYTES = 147456;
constexpr int NPHASE = 10;
#ifndef ZF_WIN
#define ZF_WIN false
#endif
#ifndef ZF_PP
#define ZF_PP true
#endif

struct Args { const float* in[23]; float* out; unsigned char* ws; int ph_lo, ph_hi; };

__device__ __forceinline__ float wave_sum(float v) {
#pragma unroll
    for (int o = 1; o < 64; o <<= 1) v += __shfl_xor(v, o);
    return v;
}

__device__ __forceinline__ void transpose_item(const float* W, int ldw, const float* gain, bf16_t* dst, int ldd, LAS float* scr, int lane, bool zero) {
    if (!zero) {
        float v[32];
#pragma unroll
        for (int i = 0; i < 32; ++i) { const int kk = 2 * i + (lane >> 5); v[i] = __builtin_nontemporal_load(W + (size_t)kk * ldw + (lane & 31)); }
#pragma unroll
        for (int i = 0; i < 32; ++i) { const int kk = 2 * i + (lane >> 5); scr[kk * 33 + (lane & 31)] = gain ? v[i] * gain[kk] : v[i]; }
    }
    asm volatile("s_waitcnt lgkmcnt(0)" ::: "memory");
    const int c = lane & 7;
#pragma unroll
    for (int j = 0; j < 4; ++j) { const int n = (lane >> 3) + 8 * j; const LAS float* s = scr + (8 * c) * 33 + n;
        u32x4 o = {0u, 0u, 0u, 0u};
        if (!zero) { o.x = pk2(s[0 * 33], s[1 * 33]); o.y = pk2(s[2 * 33], s[3 * 33]); o.z = pk2(s[4 * 33], s[5 * 33]); o.w = pk2(s[6 * 33], s[7 * 33]); }
        *(u32x4*)(dst + (size_t)n * ldd + 8 * c) = o; }
    asm volatile("s_waitcnt lgkmcnt(0)" ::: "memory");
}

__device__ __forceinline__ void p0_prep(const Args& a, LAS unsigned char* lds, int G) {
    const int tid = threadIdx.x, lane = tid & 63, wave = tid >> 6;
    unsigned char* ws = a.ws;
    LAS float* scr = (LAS float*)(lds + wave * 16384);
    const int gw = blockIdx.x * 8 + wave, NGW = G * 8;
    constexpr int I_GU = (DM / 64) * (FF / 32), I_DN = (FF / 64) * (DM / 32), I_IN = (DM / 64) * (MIXIN / 32), I_SQ = (DM / 64) * (DM / 32), I_PP = (PLE / 64) * (DM / 32), I_PL = (POOLW / 64) * (POOLW / 32);
    constexpr int NITEMS = 4 * I_GU + 2 * I_DN + I_IN + 2 * I_SQ + I_PP + I_PL;
    for (int it = gw; it < NITEMS; it += NGW) {
        int r = it; const float* W; const float* gain = nullptr; bf16_t* dst; int ldw, ldd; bool zero = false;
        if (r < 4 * I_GU) {
            const int which = r / I_GU; r -= which * I_GU; const int nblk = FF / 32, kb = r / nblk, nb = r % nblk, k0 = 64 * kb, n0 = 32 * nb;
            const int drow = (n0 / 128) * 256 + (which & 1) * 128 + (n0 % 128);
            W = a.in[which == 0 ? 3 : which == 1 ? 4 : which == 2 ? 17 : 18] + (size_t)k0 * FF + n0; ldw = FF; gain = a.in[which < 2 ? 2 : 16] + k0;
            dst = (bf16_t*)(ws + (which < 2 ? WS_WGU1 : WS_WGU2)) + (size_t)drow * DM + k0; ldd = DM;
        } else if ((r -= 4 * I_GU) < 2 * I_DN) {
            const int which = r / I_DN; r -= which * I_DN; const int nblk = DM / 32, kb = r / nblk, nb = r % nblk, k0 = 64 * kb, n0 = 32 * nb;
            W = a.in[which == 0 ? 5 : 19] + (size_t)k0 * DM + n0; ldw = DM; dst = (bf16_t*)(ws + (which == 0 ? WS_WD1 : WS_WD2)) + (size_t)n0 * FF + k0; ldd = FF;
        } else if ((r -= 2 * I_DN) < I_IN) { const int nblk = MIXIN / 32, kb = r / nblk, nb = r % nblk, k0 = 64 * kb, n0 = 32 * nb;
            W = a.in[7] + (size_t)k0 * MIXIN + n0; ldw = MIXIN; gain = a.in[6] + k0; dst = (bf16_t*)(ws + WS_WIN) + (size_t)n0 * DM + k0; ldd = DM;
        } else if ((r -= I_IN) < I_SQ) { const int nblk = DM / 32, kb = r / nblk, nb = r % nblk, k0 = 64 * kb, n0 = 32 * nb;
            W = a.in[15] + (size_t)k0 * DM + n0; ldw = DM; gain = (k0 < 512) ? a.in[13] + k0 : a.in[14] + (k0 - 512); dst = (bf16_t*)(ws + WS_WOUT) + (size_t)n0 * DM + k0; ldd = DM;
        } else if ((r -= I_SQ) < I_SQ) { const int nblk = DM / 32, kb = r / nblk, nb = r % nblk, k0 = 64 * kb, n0 = 32 * nb;
            W = a.in[21] + (size_t)k0 * DM + n0; ldw = DM; gain = a.in[20] + k0; dst = (bf16_t*)(ws + WS_WPG) + (size_t)n0 * DM + k0; ldd = DM;
        } else if ((r -= I_SQ) < I_PP) { const int nblk = DM / 32, kb = r / nblk, nb = r % nblk, k0 = 64 * kb, n0 = 32 * nb;
            W = a.in[22] + (size_t)k0 * DM + n0; ldw = DM; dst = (bf16_t*)(ws + WS_WPP) + (size_t)n0 * PLE + k0; ldd = PLE;
        } else { r -= I_PP; const int nblk = POOLW / 32, kb = r / nblk, nb = r % nblk, k0 = 64 * kb, n0 = 32 * nb, gk = k0 / 128, gn = n0 / 128;
            W = a.in[8] + (size_t)gk * 128 * 128 + (size_t)(k0 % 128) * 128 + (n0 % 128); ldw = 128; dst = (bf16_t*)(ws + WS_WPOOL) + (size_t)n0 * POOLW + k0; ldd = POOLW; zero = (gk != gn); }
        transpose_item(W, ldw, gain, dst, ldd, scr, lane, zero);
    }
    float* ss = (float*)(ws + WS_SS);
    bf16_t* xb = (bf16_t*)(ws + WS_XB); bf16_t* pb = (bf16_t*)(ws + WS_PB);
    for (int m0 = gw * 4; m0 < T; m0 += NGW * 4) {
        f32x4 v[4][4]; f32x4 pv[4];
#pragma unroll
        for (int r = 0; r < 4; ++r) { const f32x4* xr = (const f32x4*)(a.in[0] + (size_t)(m0 + r) * DM) + lane;
#pragma unroll
            for (int j = 0; j < 4; ++j) v[r][j] = __builtin_nontemporal_load(xr + 64 * j);
            pv[r] = __builtin_nontemporal_load((const f32x4*)(a.in[1] + (size_t)(m0 + r) * PLE) + lane); }
#pragma unroll
        for (int r = 0; r < 4; ++r) { float s = 0.f; u32x2* o8 = (u32x2*)(xb + (size_t)(m0 + r) * DM) + lane;
#pragma unroll
            for (int j = 0; j < 4; ++j) { s += pg8::sq4(v[r][j]); u32x2 w; w.x = pk2(v[r][j][0], v[r][j][1]); w.y = pk2(v[r][j][2], v[r][j][3]); o8[64 * j] = w; }
            s = wave_sum(s); if (lane == 0) ss[m0 + r] = s;
            u32x2 w; w.x = pk2(pv[r][0], pv[r][1]); w.y = pk2(pv[r][2], pv[r][3]); *((u32x2*)(pb + (size_t)(m0 + r) * PLE) + lane) = w; }
    }
    for (int i = blockIdx.x * 512 + tid; i < 5 * T; i += G * 512) ss[T + i] = 0.f;
}

__device__ __forceinline__ void unpack8(const u32x4 r, float (&f)[8]) { f[0] = bf_lo(r.x); f[1] = bf_hi(r.x); f[2] = bf_lo(r.y); f[3] = bf_hi(r.y); f[4] = bf_lo(r.z); f[5] = bf_hi(r.z); f[6] = bf_lo(r.w); f[7] = bf_hi(r.w); }
template <int WIN> __device__ __forceinline__ void pool_run(const bf16_t* z, bf16_t* dp, int t0, int ch) {
    const int s0 = t0 & (SEQ - 1);
    u32x4 raw[WIN + 7];
#pragma unroll
    for (int j = 0; j < WIN + 7; ++j) { const int dt = j - (WIN - 1); raw[j] = (u32x4){0u, 0u, 0u, 0u};
        if (s0 + dt >= 0) raw[j] = *(const u32x4*)(z + (unsigned)((t0 + dt) * MIXIN + ch * 8)); }
    float S[8];
#pragma unroll
    for (int e = 0; e < 8; ++e) S[e] = 0.f;
#pragma unroll
    for (int j = 0; j < WIN; ++j) { float f[8]; unpack8(raw[j], f);
#pragma unroll
        for (int e = 0; e < 8; ++e) S[e] += f[e]; }
#pragma unroll
    for (int i = 0; i < 8; ++i) {
        const int cnt = (s0 + i + 1) < WIN ? (s0 + i + 1) : WIN; const float inv = 1.0f / (float)cnt;
        float self[8]; unpack8(raw[i + WIN - 1], self);
        u32x4 o; o.x = pk2(S[0] * inv - self[0], S[1] * inv - self[1]); o.y = pk2(S[2] * inv - self[2], S[3] * inv - self[3]);
        o.z = pk2(S[4] * inv - self[4], S[5] * inv - self[5]); o.w = pk2(S[6] * inv - self[6], S[7] * inv - self[7]);
        *(u32x4*)(dp + (unsigned)((t0 + i) * POOLW + ch * 8)) = o;
        if (i < 7) { float fa[8], fb[8]; unpack8(raw[i + WIN], fa); unpack8(raw[i], fb);
#pragma unroll
            for (int e = 0; e < 8; ++e) S[e] += fa[e] - fb[e]; }
    }
}
__device__ __forceinline__ void p4_pool_diff(const bf16_t* z, bf16_t* dp, int wt_begin, int wt_end, int wt_step) {
    const int lane = threadIdx.x & 63;
    for (int wt = wt_begin; wt < wt_end; wt += wt_step) {
        const int g = wt & 3, run = 4 * (wt >> 2) + (lane >> 4), ch = g * 16 + (lane & 15), t0 = run * 8;
        if (g == 0) pool_run<2>(z, dp, t0, ch); else if (g == 1) pool_run<4>(z, dp, t0, ch); else if (g == 2) pool_run<8>(z, dp, t0, ch); else pool_run<16>(z, dp, t0, ch);
    }
}

constexpr int ATT_KS = 144, ATT_VS = 392, ATT_KBYTES = 2 * 192 * ATT_KS;
__device__ __forceinline__ void p5_attention(LAS unsigned char* lds, const bf16_t* z, bf16_t* merged, float* ssa, const float* qn, const float* kn, const float* sinks, int item_begin, int item_end, int item_step) {
    const int tid = threadIdx.x, lane = tid & 63, wave = __builtin_amdgcn_readfirstlane(tid >> 6);
    const int c = tid & 31, r0c = tid >> 5; const bool isK = c < 16; const int kvh_s = (c & 15) >> 3, d8 = c & 7;
    float gprod[8];
#pragma unroll
    for (int e = 0; e < 8; ++e) gprod[e] = qn[d8 * 8 + e] * kn[d8 * 8 + e];
    const int h = wave, kvh = h >> 2, qq = lane & 31, hh = lane >> 5;
    const float sink2 = sinks[h] * LOG2E;
    for (int item = item_begin; item < item_end; item += item_step) {
        const int b = item >> 5, rem = item & 31, n = rem >> 1, half = rem & 1;
        const int tok0 = b * SEQ + n * 128 + 64 * half;
        int r0 = r0c; asm volatile("" : "+v"(r0));
        u32x4 raws[12];
#pragma unroll
        for (int it = 0; it < 12; ++it) { const int kk = r0 + 16 * it; const bool valid = (n > 0) || (64 * half + kk >= 128);
            raws[it] = (u32x4){0u, 0u, 0u, 0u};
            if (valid) raws[it] = *(const u32x4*)(z + (size_t)(tok0 - 128 + kk) * MIXIN + 1024 + c * 8); }
#pragma unroll
        for (int it = 0; it < 12; ++it) {
            const int kk = r0 + 16 * it; const u32x4 raw = raws[it];
            const float f[8] = {bf_lo(raw.x), bf_hi(raw.x), bf_lo(raw.y), bf_hi(raw.y), bf_lo(raw.z), bf_hi(raw.z), bf_lo(raw.w), bf_hi(raw.w)};
            float s = 0.f;
#pragma unroll
            for (int e = 0; e < 8; ++e) s += f[e] * f[e];
            s += __shfl_xor(s, 1); s += __shfl_xor(s, 2); s += __shfl_xor(s, 4);
            if (isK) { const float r = fast_rsq(s * (1.0f / 64.0f) + EPS); u32x4 o;
                o.x = pk2(f[0] * r * gprod[0], f[1] * r * gprod[1]); o.y = pk2(f[2] * r * gprod[2], f[3] * r * gprod[3]);
                o.z = pk2(f[4] * r * gprod[4], f[5] * r * gprod[5]); o.w = pk2(f[6] * r * gprod[6], f[7] * r * gprod[7]);
                *(LAS u32x4*)(lds + (kvh_s * 192 + kk) * ATT_KS + d8 * 16) = o;
            } else {
                LAS unsigned char* vb = lds + ATT_KBYTES + (kvh_s * 64 + d8 * 8) * ATT_VS + kk * 2;
                *(LAS unsigned short*)(vb + 0 * ATT_VS) = (unsigned short)(raw.x & 0xffffu); *(LAS unsigned short*)(vb + 1 * ATT_VS) = (unsigned short)(raw.x >> 16);
                *(LAS unsigned short*)(vb + 2 * ATT_VS) = (unsigned short)(raw.y & 0xffffu); *(LAS unsigned short*)(vb + 3 * ATT_VS) = (unsigned short)(raw.y >> 16);
                *(LAS unsigned short*)(vb + 4 * ATT_VS) = (unsigned short)(raw.z & 0xffffu); *(LAS unsigned short*)(vb + 5 * ATT_VS) = (unsigned short)(raw.z >> 16);
                *(LAS unsigned short*)(vb + 6 * ATT_VS) = (unsigned short)(raw.w & 0xffffu); *(LAS unsigned short*)(vb + 7 * ATT_VS) = (unsigned short)(raw.w >> 16);
            }
        }
        u32x4 qraw2[2][4];
#pragma unroll
        for (int qt = 0; qt < 2; ++qt) { const bf16_t* qp = z + (size_t)(tok0 + 32 * qt + qq) * MIXIN + 512 + h * 64 + 8 * hh;
#pragma unroll
            for (int s = 0; s < 4; ++s) qraw2[qt][s] = *(const u32x4*)(qp + 16 * s); }
        __syncthreads();
#pragma unroll 1
        for (int qt = 0; qt < 2; ++qt) {
            const int tokq = tok0 + 32 * qt + qq;
            u32x4 qraw[4];
#pragma unroll
            for (int s = 0; s < 4; ++s) qraw[s] = qt ? qraw2[1][s] : qraw2[0][s];
            float ssq = 0.f;
#pragma unroll
            for (int s = 0; s < 4; ++s) { const float f[8] = {bf_lo(qraw[s].x), bf_hi(qraw[s].x), bf_lo(qraw[s].y), bf_hi(qraw[s].y), bf_lo(qraw[s].z), bf_hi(qraw[s].z), bf_lo(qraw[s].w), bf_hi(qraw[s].w)};
#pragma unroll
                for (int e = 0; e < 8; ++e) ssq += f[e] * f[e]; }
            ssq += __shfl_xor(ssq, 32);
            const float qs = fast_rsq(ssq * (1.0f / 64.0f) + EPS) * (0.125f * LOG2E);
            bf16x8 Qf[4];
#pragma unroll
            for (int s = 0; s < 4; ++s) { u32x4 o;
                o.x = pk2(bf_lo(qraw[s].x) * qs, bf_hi(qraw[s].x) * qs); o.y = pk2(bf_lo(qraw[s].y) * qs, bf_hi(qraw[s].y) * qs);
                o.z = pk2(bf_lo(qraw[s].z) * qs, bf_hi(qraw[s].z) * qs); o.w = pk2(bf_lo(qraw[s].w) * qs, bf_hi(qraw[s].w) * qs);
                Qf[s] = __builtin_bit_cast(bf16x8, o); }
            f32x16 S[5];
#pragma unroll
            for (int tt = 0; tt < 5; ++tt) {
#pragma unroll
                for (int i = 0; i < 16; ++i) S[tt][i] = 0.f;
#pragma unroll
                for (int s = 0; s < 4; ++s) { const bf16x8 Kf = *(const LAS bf16x8*)(lds + (kvh * 192 + 32 * qt + 32 * tt + qq) * ATT_KS + (16 * s + 8 * hh) * 2);
                    S[tt] = __builtin_amdgcn_mfma_f32_32x32x16_bf16(Kf, Qf[s], S[tt], 0, 0, 0); }
            }
            float mx = -1e30f;
#pragma unroll
            for (int tt = 0; tt < 5; ++tt)
#pragma unroll
                for (int i = 0; i < 16; ++i) { const int jj = 32 * tt + (i & 3) + 8 * (i >> 2) + 4 * hh;
                    const bool valid = (jj > qq) && (jj <= qq + 128) && ((n > 0) || (64 * half + 32 * qt + jj >= 128));
                    const float v = valid ? S[tt][i] : -1e30f; S[tt][i] = v; mx = fmaxf(mx, v); }
            mx = fmaxf(mx, __shfl_xor(mx, 32)); mx = fmaxf(mx, sink2);
            float sum = 0.f;
#pragma unroll
            for (int tt = 0; tt < 5; ++tt)
#pragma unroll
                for (int i = 0; i < 16; ++i) { const float e = fast_exp2(S[tt][i] - mx); S[tt][i] = e; sum += e; }
            sum += __shfl_xor(sum, 32);
            const float inv = fast_rcp(sum + fast_exp2(sink2 - mx));
            f32x16 O[2];
#pragma unroll
            for (int dt = 0; dt < 2; ++dt)
#pragma unroll
                for (int i = 0; i < 16; ++i) O[dt][i] = 0.f;
#pragma unroll
            for (int tt = 0; tt < 5; ++tt)
#pragma unroll
                for (int c2 = 0; c2 < 2; ++c2) { u32x4 pw;
                    pw.x = pk2(S[tt][8 * c2 + 0], S[tt][8 * c2 + 1]); pw.y = pk2(S[tt][8 * c2 + 2], S[tt][8 * c2 + 3]);
                    pw.z = pk2(S[tt][8 * c2 + 4], S[tt][8 * c2 + 5]); pw.w = pk2(S[tt][8 * c2 + 6], S[tt][8 * c2 + 7]);
                    const bf16x8 Pf = __builtin_bit_cast(bf16x8, pw);
#pragma unroll
                    for (int dt = 0; dt < 2; ++dt) { const LAS unsigned char* vp = lds + ATT_KBYTES + (kvh * 64 + 32 * dt + qq) * ATT_VS + (32 * qt + 32 * tt + 16 * c2 + 4 * hh) * 2;
                        const u32x2 v0 = *(const LAS u32x2*)vp, v1 = *(const LAS u32x2*)(vp + 16); const u32x4 vv = {v0.x, v0.y, v1.x, v1.y};
                        O[dt] = __builtin_amdgcn_mfma_f32_32x32x16_bf16(__builtin_bit_cast(bf16x8, vv), Pf, O[dt], 0, 0, 0); } }
            float sq = 0.f;
#pragma unroll
            for (int dt = 0; dt < 2; ++dt)
#pragma unroll
                for (int i = 0; i < 16; ++i) { const float v = O[dt][i] * inv; O[dt][i] = v; sq += v * v; }
            sq += __shfl_xor(sq, 32);
            if (hh == 0) atomic_addf(ssa + tokq, sq);
            bf16_t* op = merged + (size_t)tokq * DM + 512 + h * 64 + 4 * hh;
#pragma unroll
            for (int dt = 0; dt < 2; ++dt)
#pragma unroll
                for (int i4 = 0; i4 < 4; ++i4) { u32x2 w; w.x = pk2(O[dt][4 * i4 + 0], O[dt][4 * i4 + 1]); w.y = pk2(O[dt][4 * i4 + 2], O[dt][4 * i4 + 3]);
                    *(u32x2*)(op + 32 * dt + 8 * i4) = w; }
        }
        __syncthreads();
    }
}

__device__ __forceinline__ void group_barrier(unsigned* cnt, unsigned target, bool one_xcd) {
    asm volatile("s_waitcnt vmcnt(0)" ::: "memory");
    __syncthreads();
    if (threadIdx.x == 0) {
        if (!one_xcd) __builtin_amdgcn_fence(__ATOMIC_RELEASE, "agent");
        asm volatile("s_waitcnt vmcnt(0)" ::: "memory");
        __hip_atomic_fetch_add(cnt, 1u, __ATOMIC_RELAXED, __HIP_MEMORY_SCOPE_AGENT);
        unsigned spins = 0;
        while (__hip_atomic_load(cnt, __ATOMIC_RELAXED, __HIP_MEMORY_SCOPE_AGENT) < target) { __builtin_amdgcn_s_sleep(2); if (++spins > (1u << 22)) break; }
        __builtin_amdgcn_fence(__ATOMIC_ACQUIRE, "agent");
        asm volatile("s_waitcnt vmcnt(0)" ::: "memory");
    }
    __syncthreads();
}

__global__ void __launch_bounds__(512, 2) mk_fwd(Args a) {
    extern __shared__ __attribute__((aligned(16))) unsigned char lds_raw[];
    LAS unsigned char* lds = (LAS unsigned char*)lds_raw;
    cg::grid_group grid = cg::this_grid();
    const int G = gridDim.x, lo = a.ph_lo, hi = a.ph_hi;
    const int vcu = (int)(blockIdx.x % 8) * (G / 8) + (int)(blockIdx.x / 8);
    constexpr int GS = pg8::GS, NSEQ = GS / 8;
    const int pl = vcu / GS, rk = vcu % GS;
    const int wv = __builtin_amdgcn_readfirstlane(threadIdx.x >> 6);
    unsigned char* ws = a.ws;
    unsigned* gcnt = (unsigned*)(ws + WS_CTL) + 64 * pl; unsigned gtarget = 0;
    float* ss0 = (float*)(ws + WS_SS); float* ss1 = ss0 + T; float* ssp = ss0 + 2 * T; float* ssa = ss0 + 3 * T; float* ss2 = ss0 + 4 * T; float* ss3 = ss0 + 5 * T;
    bf16_t* XB = (bf16_t*)(ws + WS_XB); bf16_t* PB = (bf16_t*)(ws + WS_PB); bf16_t* PP = (bf16_t*)(ws + WS_PP); bf16_t* ACT = (bf16_t*)(ws + WS_ACT);
    bf16_t* Z = (bf16_t*)(ws + WS_ACT + (size_t)(NSEQ * 6 * pl) * MiB); bf16_t* DP = (bf16_t*)(ws + WS_ACT + (size_t)(NSEQ * (9 * pl + 5)) * MiB); bf16_t* MG = (bf16_t*)(ws + WS_ACT + (size_t)(NSEQ * (7 * pl + 7)) * MiB);
    float* X = a.out;
#ifndef PHMASK
#define PHMASK 0x3ff
#endif
#define IN(k) (((PHMASK >> (k)) & 1) && lo <= (k) && (k) < hi)
#define SEAM(k) do { if (IN(k) && IN((k) + 1)) { gtarget += GS; group_barrier(gcnt, gtarget, one_xcd); } } while (0)
    bool one_xcd = false;
    if (IN(0) && blockIdx.x == 0) __hip_atomic_store((unsigned*)(ws + WS_CTL) + threadIdx.x, 0u, __ATOMIC_RELAXED, __HIP_MEMORY_SCOPE_AGENT);
    if (IN(0)) { p0_prep(a, lds, G); __syncthreads(); }
    if (IN(0) && IN(1)) {
        grid.sync();
        if (threadIdx.x == 0) __hip_atomic_fetch_or(gcnt + 1, 1u << ((unsigned)__builtin_amdgcn_s_getreg((3 << 11) | 20) & 0xFu), __ATOMIC_RELAXED, __HIP_MEMORY_SCOPE_AGENT);
    }
    if (IN(1)) { pg8::Gemm g{XB, (const bf16_t*)(ws + WS_WGU1), T, NGU, DM, DM, 0}; pg8::GroupOrder S; S.init(NGU, pl, rk);
        pg8::EpiSwiGLU E{ACT, ss0}; pg8::gemm_phase<pg8::EpiSwiGLU, pg8::GroupOrder>(lds, g, S, E); }
    SEAM(1);
    if (IN(0) && IN(2)) { const unsigned m = (unsigned)__builtin_amdgcn_readfirstlane((int)__hip_atomic_load(gcnt + 1, __ATOMIC_RELAXED, __HIP_MEMORY_SCOPE_AGENT)); one_xcd = (m != 0u) && ((m & (m - 1u)) == 0u); }
    if (IN(2)) { pg8::Gemm g{ACT, (const bf16_t*)(ws + WS_WD1), T, DM, FF, FF, 0}; pg8::GroupOrder S; S.init(DM, pl, rk);
        pg8::EpiResid<false, true> E{a.in[0], XB, ss1, 0.5f, nullptr, nullptr}; pg8::gemm_phase<pg8::EpiResid<false, true>, pg8::GroupOrder>(lds, g, S, E); }
    SEAM(2);
    if (IN(3)) { pg8::Gemm g{XB, (const bf16_t*)(ws + WS_WIN), T, MIXIN, DM, DM, 0}; pg8::GroupOrder S; S.init(MIXIN, pl, rk);
        pg8::EpiScaleBf16<ZF_WIN> E{Z, MIXIN, ss1}; pg8::gemm_phase<pg8::EpiScaleBf16<ZF_WIN>, pg8::GroupOrder>(lds, g, S, E); }
    SEAM(3);
    if (IN(4)) { p4_pool_diff(Z, DP, pl * (256 * NSEQ) + rk * 8 + wv, (pl + 1) * (256 * NSEQ), GS * 8); }
    SEAM(4);
    if (IN(5)) { p5_attention(lds, Z, MG, ssa, a.in[10], a.in[11], a.in[12], pl * (32 * NSEQ) + rk, (pl + 1) * (32 * NSEQ), GS);
        pg8::Gemm g{DP, (const bf16_t*)(ws + WS_WPOOL), T, POOLW, POOLW, POOLW, 0}; pg8::GroupOrder S; S.init(POOLW, pl, rk);
        pg8::EpiPool E{MG, a.in[9], ssp}; pg8::gemm_phase<pg8::EpiPool, pg8::GroupOrder>(lds, g, S, E); }
    SEAM(5);
    if (IN(6)) { pg8::Gemm g{MG, (const bf16_t*)(ws + WS_WOUT), T, DM, DM, DM, 0}; pg8::GroupOrder S; S.init(DM, pl, rk);
        pg8::EpiResid<true, false> E{nullptr, XB, ss2, 1.0f, ssp, ssa}; pg8::gemm_phase<pg8::EpiResid<true, false>, pg8::GroupOrder>(lds, g, S, E); }
    SEAM(6);
    if (IN(7)) { pg8::Gemm g{XB, (const bf16_t*)(ws + WS_WGU2), T, NGU, DM, DM, 0}; pg8::GroupOrder S; S.init(NGU, pl, rk);
        pg8::EpiSwiGLU E{ACT, ss2}; pg8::gemm_phase<pg8::EpiSwiGLU, pg8::GroupOrder>(lds, g, S, E); }
    SEAM(7);
    if (IN(8)) { pg8::Gemm g{ACT, (const bf16_t*)(ws + WS_WD2), T, DM, FF, FF, 0}; pg8::GroupOrder S; S.init(DM, pl, rk);
        pg8::EpiResid<false, false> E{nullptr, XB, ss3, 0.5f, nullptr, nullptr}; pg8::gemm_phase<pg8::EpiResid<false, false>, pg8::GroupOrder>(lds, g, S, E); }
    SEAM(8);
    if (IN(9)) {
        { pg8::Gemm g{PB, (const bf16_t*)(ws + WS_WPP), T, DM, PLE, PLE, 0}; pg8::GroupOrder S; S.init(DM, pl, rk);
          pg8::EpiScaleBf16<ZF_PP> E{PP, DM, nullptr}; pg8::gemm_phase<pg8::EpiScaleBf16<ZF_PP>, pg8::GroupOrder>(lds, g, S, E); }
        { pg8::Gemm g{XB, (const bf16_t*)(ws + WS_WPG), T, DM, DM, DM, 0}; pg8::GroupOrder S; S.init(DM, pl, rk);
          pg8::EpiFinal E{X, XB, PP, ss3}; pg8::gemm_phase<pg8::EpiFinal, pg8::GroupOrder>(lds, g, S, E); }
    }
#undef IN
#undef SEAM
}

extern "C" void kernel_launch(void* const* d_in, const int* in_sizes, int n_in, void* d_out, int out_size, void* d_ws, size_t ws_size, hipStream_t stream) {
    static int grid = 0;
    if (grid == 0) {
        if (n_in != 23 || out_size != T * DM || ws_size < WS_END) { fprintf(stderr, "kernel_launch: unexpected shapes (n_in %d, out %d, ws %zu)\n", n_in, out_size, ws_size); grid = -1; return; }
        int dev = 0, cus = 0, per_cu = 0;
        (void)hipGetDevice(&dev); (void)hipDeviceGetAttribute(&cus, hipDeviceAttributeMultiprocessorCount, dev);
        if (hipFuncSetAttribute((const void*)mk_fwd, hipFuncAttributeMaxDynamicSharedMemorySize, LDS_BYTES) != hipSuccess) { fprintf(stderr, "kernel_launch: hipFuncSetAttribute failed\n"); grid = -1; return; }
        if (hipOccupancyMaxActiveBlocksPerMultiprocessor(&per_cu, (const void*)mk_fwd, 512, LDS_BYTES) != hipSuccess || per_cu < 1) { fprintf(stderr, "kernel_launch: occupancy query gave %d\n", per_cu); per_cu = 1; }
        (void)hipGetLastError();
        grid = cus * per_cu;
        if (grid != 256) { fprintf(stderr, "kernel_launch: this kernel is built for 256 co-resident workgroups (got %d)\n", grid); grid = -1; return; }
        fprintf(stderr, "kernel_launch: grid %d (cus %d x %d)\n", grid, cus, per_cu);
    }
    if (grid < 0) return;
    Args a{};
    for (int i = 0; i < 23; ++i) a.in[i] = (const float*)d_in[i];
    a.out = (float*)d_out; a.ws = (unsigned char*)d_ws;
#if MK_N_LAUNCHES == 1
    a.ph_lo = 0; a.ph_hi = NPHASE;
    void* args[] = {&a};
    hipError_t e = hipLaunchCooperativeKernel((const void*)mk_fwd, dim3(grid), dim3(512), args, LDS_BYTES, stream);
    if (e != hipSuccess) fprintf(stderr, "kernel_launch: cooperative launch failed: %s (grid %d)\n", hipGetErrorString(e), grid);
#else
    for (int p = 0; p < NPHASE; ++p) { a.ph_lo = p; a.ph_hi = p + 1; hipLaunchKernelGGL(mk_fwd, dim3(grid), dim3(512), LDS_BYTES, stream, a); }
#endif
}
```
